# Optimizing an MI355X kernel written in HIP

```python
import math
import jax, jax.numpy as jnp
from jax import lax
import numpy as np

D_MODEL = 2048
BATCH = 4
SEQ = 4096
DEPTH = 4

N_A_LAYERS = DEPTH // 2
N_B_LAYERS = DEPTH - N_A_LAYERS
MIX_WIDTH = D_MODEL
N_MEM = 256
MEM_HEADS = 4
MEM_HEAD_DIM = 128
MEM_WIDTH = MEM_HEADS * MEM_HEAD_DIM
TOK_WIDTH = MIX_WIDTH - MEM_WIDTH
S5_GROUP = 16
S5_GROUPS = TOK_WIDTH // S5_GROUP
S5_STATE = 64
S5_DT_MIN = 1e-3
S5_DT_MAX = 1e-1
MLA_NOPE = 128
MLA_ROPE = 64
MLA_V = 128
MLA_HEADS = TOK_WIDTH // MLA_V
MLA_Q_RANK = 512
MLA_KV_RANK = 512
ROPE_THETA = 10000.0
D_FF = 5632
Q_BLOCK = 128
EPS = 1e-6

kernel_name = "yoco_s5_mla_macaron_memory_trunk"


def rmsnorm(x, g):
    xf = x.astype(jnp.float32)
    y = xf * lax.rsqrt(jnp.mean(xf * xf, axis=-1, keepdims=True) + EPS)
    return (y * g.astype(jnp.float32)).astype(x.dtype)


def swiglu(h, w_gate, w_up, w_down):
    return (jax.nn.silu(h @ w_gate) * (h @ w_up)) @ w_down


def rope_tables(positions):
    inv_freq = ROPE_THETA ** (-jnp.arange(0, MLA_ROPE, 2, dtype=jnp.float32) / MLA_ROPE)
    ang = positions.astype(jnp.float32)[..., None] * inv_freq
    return jnp.cos(ang), jnp.sin(ang)


def apply_rope(t, cos, sin):
    half = t.shape[-1] // 2
    tf = t.astype(jnp.float32)
    t1, t2 = tf[..., :half], tf[..., half:]
    return jnp.concatenate([t1 * cos - t2 * sin, t1 * sin + t2 * cos], axis=-1).astype(t.dtype)


def s5_mix(u, lam_re, lam_im, b_re, b_im, c_re, c_im, d, log_dt, w_glu, b_glu):
    bsz, seq, _ = u.shape
    f32 = jnp.float32
    uf = u.astype(f32).reshape(bsz, seq, S5_GROUPS, S5_GROUP)
    lam = lax.complex(lam_re.astype(f32), lam_im.astype(f32))
    dt = jnp.exp(log_dt.astype(f32))[:, None]
    lam_bar = jnp.exp(lam * dt)
    b = lax.complex(b_re.astype(f32), b_im.astype(f32))
    b_bar = ((lam_bar - 1.0) / lam)[..., None] * b
    bu = jnp.einsum('gpc,bsgc->bsgp', b_bar, uf.astype(jnp.complex64))
    a = jnp.broadcast_to(lam_bar, bu.shape)

    def combine(left, right):
        a_l, b_l = left
        a_r, b_r = right
        return a_r * a_l, a_r * b_l + b_r

    _, states = lax.associative_scan(combine, (a, bu), axis=1)
    c = lax.complex(c_re.astype(f32), c_im.astype(f32))
    y = jnp.real(jnp.einsum('gcp,bsgp->bsgc', c, states)) + d.astype(f32).reshape(S5_GROUPS, S5_GROUP) * uf
    y = jax.nn.gelu(y.reshape(bsz, seq, TOK_WIDTH))
    y = y * jax.nn.sigmoid(y @ w_glu.astype(f32) + b_glu.astype(f32))
    return y.astype(u.dtype)


def shared_latent_kv(x, kv_in_norm, w_dkv, kv_norm, w_uk, w_uv, w_kr, cos, sin):
    bsz, seq, _ = x.shape
    h = rmsnorm(x, kv_in_norm)
    c_kv = rmsnorm(h @ w_dkv, kv_norm)
    k_nope = (c_kv @ w_uk).reshape(bsz, seq, MLA_HEADS, MLA_NOPE)
    v = (c_kv @ w_uv).reshape(bsz, seq, MLA_HEADS, MLA_V)
    k_rope = apply_rope(h @ w_kr, cos, sin)
    return k_nope, k_rope, v


def mla_attend(q_nope, q_rope, k_nope, k_rope, v):
    bsz, seq = q_nope.shape[0], q_nope.shape[1]
    scale = (MLA_NOPE + MLA_ROPE) ** -0.5
    outs = []
    for start in range(0, seq, Q_BLOCK):
        end = start + Q_BLOCK
        s = (jnp.einsum('bqhd,bkhd->bhqk', q_nope[:, start:end], k_nope[:, :end])
             + jnp.einsum('bqhr,bkr->bhqk', q_rope[:, start:end], k_rope[:, :end]))
        s = s.astype(jnp.float32) * scale
        qi = jnp.arange(start, end)[:, None]
        ki = jnp.arange(end)[None, :]
        s = jnp.where(ki <= qi, s, -jnp.inf)
        p = jax.nn.softmax(s, axis=-1).astype(v.dtype)
        outs.append(jnp.einsum('bhqk,bkhd->bqhd', p, v[:, :end]))
    o = jnp.concatenate(outs, axis=1)
    return o.reshape(bsz, seq, MLA_HEADS * MLA_V)


def mem_attend(q, mem_k, mem_v):
    bsz, seq, _ = q.shape
    qh = q.reshape(bsz, seq, MEM_HEADS, MEM_HEAD_DIM)
    s = jnp.einsum('bqhd,bkhd->bhqk', qh, mem_k).astype(jnp.float32) * (MEM_HEAD_DIM ** -0.5)
    p = jax.nn.softmax(s, axis=-1).astype(mem_v.dtype)
    return jnp.einsum('bhqk,bkhd->bqhd', p, mem_v).reshape(bsz, seq, MEM_WIDTH)


def setup_inputs(seed: int = 0) -> dict:
    key = jax.random.key(seed)
    ks = iter(jax.random.split(key, 40))
    f32 = jnp.float32

    def nrm(shape, fan_in):
        return jax.random.normal(next(ks), shape, f32) * (fan_in ** -0.5)

    def gain(shape):
        return 1.0 + 0.02 * jax.random.normal(next(ks), shape, f32)

    x = jax.random.normal(next(ks), (BATCH, SEQ, D_MODEL), f32)
    mem = jax.random.normal(next(ks), (BATCH, N_MEM, D_MODEL), f32)
    offset = jax.random.randint(next(ks), (BATCH, 1), 0, 1024, dtype=jnp.int32)
    positions = offset + jnp.arange(SEQ, dtype=jnp.int32)[None, :]

    n_idx = jnp.arange(S5_STATE, dtype=f32)[None, None, :]
    lam_re = -0.5 + 0.01 * jax.random.normal(next(ks), (N_A_LAYERS, S5_GROUPS, S5_STATE), f32)
    lam_im = math.pi * n_idx + 0.01 * jax.random.normal(next(ks), (N_A_LAYERS, S5_GROUPS, S5_STATE), f32)
    log_dt = jax.random.uniform(next(ks), (N_A_LAYERS, S5_GROUPS), f32,
                                math.log(S5_DT_MIN), math.log(S5_DT_MAX))

    return {
        'x': x,
        'mem': mem,
        'positions': positions,
        'norms': gain((DEPTH, 6, D_MODEL)),
        'ffn_w_gate': nrm((DEPTH, 2, D_MODEL, D_FF), D_MODEL),
        'ffn_w_up': nrm((DEPTH, 2, D_MODEL, D_FF), D_MODEL),
        'ffn_w_down': nrm((DEPTH, 2, D_FF, D_MODEL), D_FF),
        'w_out': nrm((DEPTH, MIX_WIDTH, D_MODEL), MIX_WIDTH),
        'mem_norm': gain((DEPTH, D_MODEL)),
        'mem_w_kv': nrm((DEPTH, D_MODEL, 2 * MEM_WIDTH), D_MODEL),
        'a_w_in': nrm((N_A_LAYERS, D_MODEL, TOK_WIDTH + MEM_WIDTH), D_MODEL),
        's5_lambda_re': lam_re,
        's5_lambda_im': lam_im,
        's5_b_re': nrm((N_A_LAYERS, S5_GROUPS, S5_STATE, S5_GROUP), 2 * S5_GROUP),
        's5_b_im': nrm((N_A_LAYERS, S5_GROUPS, S5_STATE, S5_GROUP), 2 * S5_GROUP),
        's5_c_re': nrm((N_A_LAYERS, S5_GROUPS, S5_GROUP, S5_STATE), 2 * S5_STATE),
        's5_c_im': nrm((N_A_LAYERS, S5_GROUPS, S5_GROUP, S5_STATE), 2 * S5_STATE),
        's5_d': jax.random.normal(next(ks), (N_A_LAYERS, TOK_WIDTH), f32),
        's5_log_dt': log_dt,
        's5_w_glu': nrm((N_A_LAYERS, TOK_WIDTH, TOK_WIDTH), TOK_WIDTH),
        's5_b_glu': 0.01 * jax.random.normal(next(ks), (N_A_LAYERS, TOK_WIDTH), f32),
        'b_w_in': nrm((N_B_LAYERS, D_MODEL, MLA_Q_RANK + MEM_WIDTH), D_MODEL),
        'mla_q_norm': gain((N_B_LAYERS, MLA_Q_RANK)),
        'mla_w_uq': nrm((N_B_LAYERS, MLA_Q_RANK, MLA_HEADS * (MLA_NOPE + MLA_ROPE)), MLA_Q_RANK),
        'kv_in_norm': gain((D_MODEL,)),
        'w_dkv': nrm((D_MODEL, MLA_KV_RANK), D_MODEL),
        'kv_norm': gain((MLA_KV_RANK,)),
        'w_uk': nrm((MLA_KV_RANK, MLA_HEADS * MLA_NOPE), MLA_KV_RANK),
        'w_uv': nrm((MLA_KV_RANK, MLA_HEADS * MLA_V), MLA_KV_RANK),
        'w_kr': nrm((D_MODEL, MLA_ROPE), D_MODEL),
    }


def reference(x, mem, positions, norms, ffn_w_gate, ffn_w_up, ffn_w_down, w_out,
              mem_norm, mem_w_kv, a_w_in, s5_lambda_re, s5_lambda_im, s5_b_re, s5_b_im,
              s5_c_re, s5_c_im, s5_d, s5_log_dt, s5_w_glu, s5_b_glu, b_w_in, mla_q_norm,
              mla_w_uq, kv_in_norm, w_dkv, kv_norm, w_uk, w_uv, w_kr):
    bsz, seq, _ = x.shape
    n_mem = mem.shape[1]
    cos, sin = rope_tables(positions)
    cos_h, sin_h = cos[:, :, None, :], sin[:, :, None, :]
    k_nope = k_rope = v_shared = None

    for l in range(DEPTH):
        if l == N_A_LAYERS:
            k_nope, k_rope, v_shared = shared_latent_kv(x, kv_in_norm, w_dkv, kv_norm,
                                                        w_uk, w_uv, w_kr, cos, sin)
        g = norms[l]
        h = rmsnorm(x, g[0])
        x = x + 0.5 * rmsnorm(swiglu(h, ffn_w_gate[l, 0], ffn_w_up[l, 0], ffn_w_down[l, 0]), g[1])

        mkv = rmsnorm(mem, mem_norm[l]) @ mem_w_kv[l]
        mem_k = mkv[..., :MEM_WIDTH].reshape(bsz, n_mem, MEM_HEADS, MEM_HEAD_DIM)
        mem_v = mkv[..., MEM_WIDTH:].reshape(bsz, n_mem, MEM_HEADS, MEM_HEAD_DIM)

        h = rmsnorm(x, g[2])
        if l < N_A_LAYERS:
            z = h @ a_w_in[l]
            tok = s5_mix(z[..., :TOK_WIDTH], s5_lambda_re[l], s5_lambda_im[l], s5_b_re[l],
                         s5_b_im[l], s5_c_re[l], s5_c_im[l], s5_d[l], s5_log_dt[l],
                         s5_w_glu[l], s5_b_glu[l])
            q_mem = z[..., TOK_WIDTH:]
        else:
            j = l - N_A_LAYERS
            z = h @ b_w_in[j]
            c_q = rmsnorm(z[..., :MLA_Q_RANK], mla_q_norm[j])
            q = (c_q @ mla_w_uq[j]).reshape(bsz, seq, MLA_HEADS, MLA_NOPE + MLA_ROPE)
            q_nope = q[..., :MLA_NOPE]
            q_rope = apply_rope(q[..., MLA_NOPE:], cos_h, sin_h)
            tok = mla_attend(q_nope, q_rope, k_nope, k_rope, v_shared)
            q_mem = z[..., MLA_Q_RANK:]
        mem_o = mem_attend(q_mem, mem_k, mem_v)
        o = jnp.concatenate([tok, mem_o], axis=-1) @ w_out[l]
        x = x + rmsnorm(o, g[3])

        h = rmsnorm(x, g[4])
        x = x + 0.5 * rmsnorm(swiglu(h, ffn_w_gate[l, 1], ffn_w_up[l, 1], ffn_w_down[l, 1]), g[5])
    return x
```

```cpp
#include <hip/hip_runtime.h>
#include <cstdio>
#include <cstdint>

#ifndef MK_PER_PHASE
#define MK_PER_PHASE 0
#endif

#ifndef EN_MASK
#define EN_MASK 0xFFFF
#endif
#define EN(b) ((EN_MASK >> (b)) & 1)
constexpr int DM = 2048, BATCH = 4, SEQ = 4096, M = BATCH * SEQ, DEPTH = 4, NA = 2;
constexpr int NMEM = 256, MEMW = 512, TOKW = 1536, DFF = 5632;
constexpr int S5G = 96, S5P = 64, S5C = 16, S5T = 16, NCHUNK = M / S5T, CPB = SEQ / S5T;
constexpr int QRANK = 512, KVRANK = 512, NH = 12, DNOPE = 128, DROPE = 64, DQKH = 192, DVH = 128;
constexpr float EPS = 1e-6f;
constexpr int YGS = NCHUNK * 256;

#define GAS __attribute__((address_space(1)))
#define LAS __attribute__((address_space(3)))
typedef unsigned short bf16_t;
typedef short bf16x8 __attribute__((ext_vector_type(8)));
typedef short s16x4 __attribute__((ext_vector_type(4)));
typedef float f32x4 __attribute__((ext_vector_type(4)));
typedef float f32x2 __attribute__((ext_vector_type(2)));
typedef float f32x16 __attribute__((ext_vector_type(16)));
typedef unsigned u32x4 __attribute__((ext_vector_type(4)));
typedef unsigned u32x2 __attribute__((ext_vector_type(2)));

__device__ __forceinline__ unsigned cvt_pk_bf16(float lo, float hi) { unsigned r; asm volatile("v_cvt_pk_bf16_f32 %0, %1, %2" : "=v"(r) : "v"(lo), "v"(hi)); return r; }
__device__ __forceinline__ u32x4 pack8(f32x4 a, f32x4 b) { u32x4 w; w.x = cvt_pk_bf16(a[0], a[1]); w.y = cvt_pk_bf16(a[2], a[3]); w.z = cvt_pk_bf16(b[0], b[1]); w.w = cvt_pk_bf16(b[2], b[3]); return w; }
__device__ __forceinline__ float bf2f(unsigned short b) { return __uint_as_float(((unsigned)b) << 16); }
__device__ __forceinline__ void unpack8(u32x4 w, float* o) { o[0] = __uint_as_float(w.x << 16); o[1] = __uint_as_float(w.x & 0xffff0000u); o[2] = __uint_as_float(w.y << 16); o[3] = __uint_as_float(w.y & 0xffff0000u);
    o[4] = __uint_as_float(w.z << 16); o[5] = __uint_as_float(w.z & 0xffff0000u); o[6] = __uint_as_float(w.w << 16); o[7] = __uint_as_float(w.w & 0xffff0000u); }
__device__ __forceinline__ float fast_sigmoid(float v) { return __builtin_amdgcn_rcpf(1.0f + __builtin_amdgcn_exp2f(-1.4426950408889634f * v)); }
__device__ __forceinline__ float gelu_tanh(float v) { const float u = 0.7978845608028654f * (v + 0.044715f * v * v * v); const float t = 1.0f - 2.0f * __builtin_amdgcn_rcpf(__builtin_amdgcn_exp2f(2.885390081777927f * u) + 1.0f); return 0.5f * v * (1.0f + t); }

namespace pg8 {
constexpr int BM = 256, BK = 64, HALF = 128, HTB = HALF * BK * 2, STAGE_BYTES = 8 * HTB, NXCD = 8, WGM = 8;
__host__ __device__ __forceinline__ int lds_byte(int r, int c) { const int st = (r >> 4) * 2 + (c >> 5), rr = r & 15, cc = c & 31, ob = rr * 64 + cc * 2; return st * 1024 + (ob ^ (((ob >> 9) & 1) << 5)); }
__host__ __device__ __forceinline__ void stage_rc(int b, int& R, int& C) { const int st = b / 1024, sb = b % 1024, swz = sb ^ (((sb >> 9) & 1) << 5); R = (st >> 1) * 16 + swz / 64; C = (st & 1) * 32 + (swz % 64) / 2; }
__host__ __device__ __forceinline__ int perm32(int rho) { const int n = rho >> 4, i = rho & 15; return 8 * (i >> 2) + 4 * n + (i & 3); }

struct Unit { int pm, pn; };
struct Gemm { const bf16_t* A; const bf16_t* Bt; int K; int lda; int ldb; };

struct StaticOrder {
    int nM, nN, nwg, G, c;
    __device__ __forceinline__ void init(int nM_, int nN_, int G_, int c_) { nM = nM_; nN = nN_; nwg = nM * nN; G = G_; c = c_; }
    __device__ __forceinline__ bool next(int i, Unit& u) const {
        const long L = (long)i * G + c; if (L >= nwg) return false;
        int wgid = (int)L; { const int q = nwg / NXCD, r = nwg % NXCD, xcd = wgid % NXCD, off = wgid / NXCD; wgid = (xcd < r ? xcd * (q + 1) : r * (q + 1) + (xcd - r) * q) + off; }
        const int nig = WGM * nN, gid = wgid / nig, fm = gid * WGM, gsz = (nM - fm) < WGM ? (nM - fm) : WGM;
        u.pm = fm + ((wgid % nig) % gsz); u.pn = (wgid % nig) / gsz; return true;
    }
};
struct S5Order {
    int G, c;
    __device__ __forceinline__ bool next(int i, Unit& u) const { const int L = i * G + c; if (L >= S5G * 4) return false; u.pm = L; u.pn = L >> 2; return true; }
};
struct MemKvOrder {
    int G, c;
    __device__ __forceinline__ bool next(int i, Unit& u) const { const int L = i * G + c; if (L >= 64) return false; const int l = L >> 4, r = L & 15; u.pm = l * 4 + (r >> 2); u.pn = l * 4 + (r & 3); return true; }
};

struct EpiBf16 {
    static constexpr bool PERM = true;
    bf16_t* O; int ldc;
    __device__ __forceinline__ void operator()(const f32x4 (&acc)[2][2][4][2], const Unit& u, int wr, int wc, int fr, int fq) const {
        const int row0 = u.pm * BM + wr * 64 + fr, col0 = u.pn * BM + wc * 32 + 8 * fq;
#pragma unroll
        for (int ai = 0; ai < 2; ++ai)
#pragma unroll
            for (int m = 0; m < 4; ++m) { bf16_t* rowp = O + (size_t)(row0 + ai * HALF + m * 16) * ldc + col0;
#pragma unroll
                for (int bj = 0; bj < 2; ++bj) *(u32x4*)(rowp + bj * HALF) = pack8(acc[ai][bj][m][0], acc[ai][bj][m][1]); }
    }
};
struct EpiMemKv {
    static constexpr bool PERM = true;
    bf16_t* O;
    __device__ __forceinline__ void operator()(const f32x4 (&acc)[2][2][4][2], const Unit& u, int wr, int wc, int fr, int fq) const {
        const int row0 = u.pm * BM + wr * 64 + fr, col0 = (u.pn & 3) * BM + wc * 32 + 8 * fq;
#pragma unroll
        for (int ai = 0; ai < 2; ++ai)
#pragma unroll
            for (int m = 0; m < 4; ++m) { bf16_t* rowp = O + (size_t)(row0 + ai * HALF + m * 16) * 1024 + col0;
#pragma unroll
                for (int bj = 0; bj < 2; ++bj) *(u32x4*)(rowp + bj * HALF) = pack8(acc[ai][bj][m][0], acc[ai][bj][m][1]); }
    }
};
struct EpiSwiGLU {
    static constexpr bool PERM = true;
    bf16_t* O;
    __device__ __forceinline__ void operator()(const f32x4 (&acc)[2][2][4][2], const Unit& u, int wr, int wc, int fr, int fq) const {
        const int row0 = u.pm * BM + wr * 64 + fr, col0 = u.pn * HALF + wc * 32 + 8 * fq;
#pragma unroll
        for (int ai = 0; ai < 2; ++ai)
#pragma unroll
            for (int m = 0; m < 4; ++m) { bf16_t* rowp = O + (size_t)(row0 + ai * HALF + m * 16) * DFF + col0;
                f32x4 v0, v1;
#pragma unroll
                for (int j = 0; j < 4; ++j) { const float g0 = acc[ai][0][m][0][j], g1 = acc[ai][0][m][1][j]; v0[j] = g0 * fast_sigmoid(g0) * acc[ai][1][m][0][j]; v1[j] = g1 * fast_sigmoid(g1) * acc[ai][1][m][1][j]; }
                *(u32x4*)rowp = pack8(v0, v1); }
    }
};
struct EpiAin {
    static constexpr bool PERM = true;
    bf16_t* UH; bf16_t* QM;
    __device__ __forceinline__ void operator()(const f32x4 (&acc)[2][2][4][2], const Unit& u, int wr, int wc, int fr, int fq) const {
        const int row0 = u.pm * BM + wr * 64 + fr;
#pragma unroll
        for (int ai = 0; ai < 2; ++ai)
#pragma unroll
            for (int m = 0; m < 4; ++m) { const int row = row0 + ai * HALF + m * 16;
#pragma unroll
                for (int bj = 0; bj < 2; ++bj) { const int c0 = u.pn * BM + bj * HALF + wc * 32 + 8 * fq; const u32x4 w = pack8(acc[ai][bj][m][0], acc[ai][bj][m][1]);
                    if (u.pn < 6) *(u32x4*)(UH + ((size_t)(c0 >> 4) * NCHUNK + (row >> 4)) * 384 + (row & 15) * 16 + (c0 & 15)) = w;
                    else *(u32x4*)(QM + (size_t)row * MEMW + (c0 - TOKW)) = w; } }
    }
};
struct EpiS5State {
    static constexpr bool PERM = false;
    float* SE;
    __device__ __forceinline__ void operator()(const f32x4 (&acc)[2][2][4][2], const Unit& u, int wr, int wc, int fr, int fq) const {
        const int row0 = u.pm * BM + wr * 64 + fr, col0 = wc * 32 + 4 * fq;
#pragma unroll
        for (int ai = 0; ai < 2; ++ai)
#pragma unroll
            for (int m = 0; m < 4; ++m) { float* rowp = SE + (size_t)(row0 + ai * HALF + m * 16) * 128 + col0;
#pragma unroll
                for (int n = 0; n < 2; ++n) *(f32x4*)(rowp + n * 16) = acc[ai][0][m][n]; }
    }
};
struct EpiS5Out {
    static constexpr bool PERM = true;
    bf16_t* Y;
    __device__ __forceinline__ void operator()(const f32x4 (&acc)[2][2][4][2], const Unit& u, int wr, int wc, int fr, int fq) const {
        const int row0 = u.pm * BM + wr * 64 + fr, col0 = wc * 32 + 8 * fq;
#pragma unroll
        for (int ai = 0; ai < 2; ++ai)
#pragma unroll
            for (int m = 0; m < 4; ++m) { bf16_t* rowp = Y + (size_t)(row0 + ai * HALF + m * 16) * 256 + col0;
#pragma unroll
                for (int bj = 0; bj < 2; ++bj) { f32x4 v0, v1;
#pragma unroll
                    for (int j = 0; j < 4; ++j) { v0[j] = gelu_tanh(acc[ai][bj][m][0][j]); v1[j] = gelu_tanh(acc[ai][bj][m][1][j]); }
                    *(u32x4*)(rowp + bj * HALF) = pack8(v0, v1); } }
    }
};
struct EpiGlu {
    static constexpr bool PERM = true;
    const bf16_t* Y; const float* bias; bf16_t* CAT;
    __device__ __forceinline__ void operator()(const f32x4 (&acc)[2][2][4][2], const Unit& u, int wr, int wc, int fr, int fq) const {
        const int row0 = u.pm * BM + wr * 64 + fr;
#pragma unroll
        for (int bj = 0; bj < 2; ++bj) { const int c0 = u.pn * BM + bj * HALF + wc * 32 + 8 * fq;
            const f32x4 b0 = *(const f32x4*)(bias + c0), b1 = *(const f32x4*)(bias + c0 + 4);
#pragma unroll
            for (int ai = 0; ai < 2; ++ai)
#pragma unroll
                for (int m = 0; m < 4; ++m) { const int row = row0 + ai * HALF + m * 16;
                    const u32x4 yw = *(const u32x4*)(Y + (size_t)(c0 >> 4) * YGS + (size_t)(row >> 4) * 256 + (row & 15) * 16 + (c0 & 15));
                    float y[8]; unpack8(yw, y); f32x4 v0, v1;
#pragma unroll
                    for (int j = 0; j < 4; ++j) { v0[j] = y[j] * fast_sigmoid(acc[ai][bj][m][0][j] + b0[j]); v1[j] = y[4 + j] * fast_sigmoid(acc[ai][bj][m][1][j] + b1[j]); }
                    *(u32x4*)(CAT + (size_t)row * DM + c0) = pack8(v0, v1); } }
    }
};
__device__ __forceinline__ void ssq_partial(const f32x4 (&acc)[2][2][4][2], int ai, int m, float* SSQ, int row, int pn, int wc, int fq) {
    float s = 0.f;
#pragma unroll
    for (int bj = 0; bj < 2; ++bj)
#pragma unroll
        for (int n = 0; n < 2; ++n) { const f32x4 x = acc[ai][bj][m][n]; s += (x[0] * x[0] + x[1] * x[1]) + (x[2] * x[2] + x[3] * x[3]); }
    s += __shfl_xor(s, 16); s += __shfl_xor(s, 32);
    if (fq == 0) SSQ[(size_t)row * 8 + pn * 4 + wc] = s;
}
struct EpiBin {
    static constexpr bool PERM = true;
    bf16_t* CQ; float* SSQ; bf16_t* QM;
    __device__ __forceinline__ void operator()(const f32x4 (&acc)[2][2][4][2], const Unit& u, int wr, int wc, int fr, int fq) const {
        const int row0 = u.pm * BM + wr * 64 + fr;
#pragma unroll
        for (int ai = 0; ai < 2; ++ai)
#pragma unroll
            for (int m = 0; m < 4; ++m) { const int row = row0 + ai * HALF + m * 16;
                if (u.pn < 2) ssq_partial(acc, ai, m, SSQ, row, u.pn, wc, fq);
#pragma unroll
                for (int bj = 0; bj < 2; ++bj) { const int c0 = u.pn * BM + bj * HALF + wc * 32 + 8 * fq; const u32x4 w = pack8(acc[ai][bj][m][0], acc[ai][bj][m][1]);
                    if (u.pn < 2) *(u32x4*)(CQ + (size_t)row * QRANK + c0) = w; else *(u32x4*)(QM + (size_t)row * MEMW + (c0 - QRANK)) = w; } }
    }
};
__device__ __forceinline__ float rstd_from_ssq(const float* SSQ, int row) { const f32x4 a = *(const f32x4*)(SSQ + (size_t)row * 8), b = *(const f32x4*)(SSQ + (size_t)row * 8 + 4);
    return 1.0f / sqrtf(((a[0] + a[1]) + (a[2] + a[3]) + (b[0] + b[1]) + (b[2] + b[3])) * (1.0f / 512.0f) + EPS); }
__device__ __forceinline__ void rope_store(f32x4 t1, f32x4 t2, const float* cs, const float* sn, int row, int i0, bf16_t* dst  ) {
    const f32x4 c = *(const f32x4*)(cs + (size_t)row * 32 + i0), s = *(const f32x4*)(sn + (size_t)row * 32 + i0);
    const f32x4 o1 = t1 * c - t2 * s, o2 = t1 * s + t2 * c;
    u32x2 w1, w2; w1.x = cvt_pk_bf16(o1[0], o1[1]); w1.y = cvt_pk_bf16(o1[2], o1[3]); w2.x = cvt_pk_bf16(o2[0], o2[1]); w2.y = cvt_pk_bf16(o2[2], o2[3]);
    *(u32x2*)(dst + i0) = w1; *(u32x2*)(dst + 32 + i0) = w2;
}
struct EpiUq {
    static constexpr bool PERM = true;
    const float* SSQ; const float* cs; const float* sn; bf16_t* Q;
    __device__ __forceinline__ void operator()(const f32x4 (&acc)[2][2][4][2], const Unit& u, int wr, int wc, int fr, int fq) const {
        const int row0 = u.pm * BM + wr * 64 + fr;
#pragma unroll
        for (int ai = 0; ai < 2; ++ai)
#pragma unroll
            for (int m = 0; m < 4; ++m) { const int row = row0 + ai * HALF + m * 16; const float rs = rstd_from_ssq(SSQ, row);
#pragma unroll
                for (int bj = 0; bj < 2; ++bj) { const int c0 = u.pn * BM + bj * HALF + wc * 32 + 8 * fq; const int h = c0 / DQKH, j = c0 - h * DQKH;
                    const f32x4 a0 = acc[ai][bj][m][0] * rs, a1 = acc[ai][bj][m][1] * rs;
                    if (j < DNOPE) *(u32x4*)(Q + (size_t)row * (NH * DQKH) + c0) = pack8(a0, a1);
                    else rope_store(a0, a1, cs, sn, row, ((j - DNOPE) >> 3) * 4, Q + (size_t)row * (NH * DQKH) + h * DQKH + DNOPE); } }
    }
};
struct EpiDkv {
    static constexpr bool PERM = true;
    bf16_t* CKV; float* SSQ; const float* cs; const float* sn; bf16_t* KR;
    __device__ __forceinline__ void operator()(const f32x4 (&acc)[2][2][4][2], const Unit& u, int wr, int wc, int fr, int fq) const {
        const int row0 = u.pm * BM + wr * 64 + fr;
#pragma unroll
        for (int ai = 0; ai < 2; ++ai)
#pragma unroll
            for (int m = 0; m < 4; ++m) { const int row = row0 + ai * HALF + m * 16;
                if (u.pn < 2) { ssq_partial(acc, ai, m, SSQ, row, u.pn, wc, fq);
#pragma unroll
                    for (int bj = 0; bj < 2; ++bj) *(u32x4*)(CKV + (size_t)row * KVRANK + u.pn * BM + bj * HALF + wc * 32 + 8 * fq) = pack8(acc[ai][bj][m][0], acc[ai][bj][m][1]); }
                else if (wc < 2) rope_store(acc[ai][0][m][0], acc[ai][0][m][1], cs, sn, row, (wc * 4 + fq) * 4, KR + (size_t)row * DROPE); }
    }
};
struct EpiUkv {
    static constexpr bool PERM = true;
    const float* SSQ; bf16_t* KN; bf16_t* VV;
    __device__ __forceinline__ void operator()(const f32x4 (&acc)[2][2][4][2], const Unit& u, int wr, int wc, int fr, int fq) const {
        const int row0 = u.pm * BM + wr * 64 + fr; bf16_t* base = u.pn < 6 ? KN : VV; const int colt = (u.pn < 6 ? u.pn : u.pn - 6) * BM + wc * 32 + 8 * fq;
#pragma unroll
        for (int ai = 0; ai < 2; ++ai)
#pragma unroll
            for (int m = 0; m < 4; ++m) { const int row = row0 + ai * HALF + m * 16; const float rs = rstd_from_ssq(SSQ, row);
#pragma unroll
                for (int bj = 0; bj < 2; ++bj) *(u32x4*)(base + (size_t)row * TOKW + colt + bj * HALF) = pack8(acc[ai][bj][m][0] * rs, acc[ai][bj][m][1] * rs); }
    }
};

template <class Epi, class Sched, int AMODE = 0, bool ALIGN_EPI = true>
__device__ __forceinline__ void gemm_phase(LAS unsigned char* lds, const Gemm g, const Sched& S, const Epi& E) {
    int tid = threadIdx.x; asm volatile("" : "+v"(tid));
    const int wid = __builtin_amdgcn_readfirstlane(tid >> 6), lane = tid & 63, wr = wid >> 2, wc = wid & 3, fr = lane & 15, fq = lane >> 4;
    const int nt = g.K / BK;
    unsigned voffA[2], voffB[2];
#pragma unroll
    for (int i = 0; i < 2; ++i) { int R, C; stage_rc(tid * 16 + i * 8192, R, C); const int Rb = Epi::PERM ? ((R & ~31) + perm32(R & 31)) : R;
        if (AMODE == 0) voffA[i] = (unsigned)(R * g.lda + C) * 2u; else voffA[i] = (unsigned)((C >> 4) * YGS + (R >> 4) * 256 + (R & 15) * 16 + (C & 15)) * 2u;
        voffB[i] = (unsigned)(Rb * g.ldb + C) * 2u; }
    const size_t kstepA = AMODE == 0 ? (size_t)(BK * 2) : (size_t)4 * YGS * 2, kstepB = (size_t)(BK * 2);
    const size_t hstepA = AMODE == 0 ? (size_t)HALF * g.lda * 2 : (size_t)8 * 256 * 2, hstepB = (size_t)HALF * g.ldb * 2;
    const size_t tstepA = 2 * hstepA, tstepB = 2 * hstepB;
    const unsigned ldsw = (unsigned)wid * 1024u;
    const int aoff = lds_byte(wr * 64 + fr, fq * 8), boff = lds_byte(wc * 32 + fr, fq * 8);
#define PG8_SA(b, h) (((b) * 2 + (h)) * HTB)
#define PG8_SB(b, h) ((4 + (b) * 2 + (h)) * HTB)
#define PG8_STAGE(bufoff, gbase, voff) do { _Pragma("unroll") for (int _i = 0; _i < 2; ++_i) \
        __builtin_amdgcn_global_load_lds((const unsigned*)((const char*)(gbase) + (voff)[_i]), (LAS unsigned*)(lds + (bufoff) + ldsw + _i * 8192), 16, 0, 0); } while (0)
#define PG8_LDA(dst, b, h) do { _Pragma("unroll") for (int m = 0; m < 4; ++m) _Pragma("unroll") for (int k = 0; k < 2; ++k) dst[m][k] = *(const LAS bf16x8*)(lds + PG8_SA(b, h) + aoff + m * 2048 + k * 1024); } while (0)
#define PG8_LDB(dst, b, h) do { _Pragma("unroll") for (int n = 0; n < 2; ++n) _Pragma("unroll") for (int k = 0; k < 2; ++k) dst[n][k] = *(const LAS bf16x8*)(lds + PG8_SB(b, h) + boff + n * 2048 + k * 1024); } while (0)
#define PG8_MMA(ai, bj, At, Bt) do { __builtin_amdgcn_s_setprio(1); _Pragma("unroll") for (int m = 0; m < 4; ++m) _Pragma("unroll") for (int n = 0; n < 2; ++n) _Pragma("unroll") for (int k = 0; k < 2; ++k) \
        acc[ai][bj][m][n] = __builtin_amdgcn_mfma_f32_16x16x32_bf16(Bt[n][k], At[m][k], acc[ai][bj][m][n], 0, 0, 0); __builtin_amdgcn_s_setprio(0); } while (0)
#define PG8_WAIT_V(n) asm volatile("s_waitcnt vmcnt(" #n ")" ::: "memory")
#define PG8_WAIT_L(n) asm volatile("s_waitcnt lgkmcnt(" #n ")" ::: "memory")
#define PG8_BAR __builtin_amdgcn_s_barrier()
#define PG8_SCHED __builtin_amdgcn_sched_barrier(0)
    Unit cur, nxt; int ui = 0;
    if (!S.next(0, cur)) return;
    f32x4 acc[2][2][4][2];
#pragma unroll
    for (int a = 0; a < 2; ++a)
#pragma unroll
        for (int b = 0; b < 2; ++b)
#pragma unroll
            for (int m = 0; m < 4; ++m)
#pragma unroll
                for (int n = 0; n < 2; ++n) acc[a][b][m][n] = (f32x4){0.f, 0.f, 0.f, 0.f};
    bf16x8 At[4][2], B0[2][2], B1[2][2];
    const char* cA = (const char*)g.A + (size_t)cur.pm * tstepA; const char* cB = (const char*)g.Bt + (size_t)cur.pn * tstepB;
    PG8_STAGE(PG8_SB(0, 0), cB, voffB); PG8_STAGE(PG8_SB(0, 1), cB + hstepB, voffB); PG8_STAGE(PG8_SA(0, 0), cA, voffA); PG8_STAGE(PG8_SA(0, 1), cA + hstepA, voffA);
    if (wr == 1) PG8_BAR;
    PG8_WAIT_V(2); PG8_BAR;
    PG8_STAGE(PG8_SB(1, 0), cB + kstepB, voffB); PG8_STAGE(PG8_SA(1, 0), cA + kstepA, voffA); PG8_STAGE(PG8_SB(1, 1), cB + hstepB + kstepB, voffB);
    PG8_WAIT_V(6); PG8_BAR;
    for (;;) {
        const bool has_next = S.next(ui + 1, nxt);
        const char* nA = has_next ? (const char*)g.A + (size_t)nxt.pm * tstepA : cA; const char* nB = has_next ? (const char*)g.Bt + (size_t)nxt.pn * tstepB : cB;
        for (int t = 0; t < nt; t += 2) {
            const bool last = (t == nt - 2);
            const char* a1 = cA + (size_t)(t + 1) * kstepA;
            const char* a2 = last ? nA : cA + (size_t)(t + 2) * kstepA; const char* b2 = last ? nB : cB + (size_t)(t + 2) * kstepB;
            const char* a3 = a2 + kstepA; const char* b3 = b2 + kstepB;
            PG8_LDB(B0, 0, 0); PG8_LDB(B1, 0, 1); PG8_SCHED; PG8_LDA(At, 0, 0); PG8_STAGE(PG8_SA(1, 1), a1 + hstepA, voffA);
            PG8_WAIT_V(8); PG8_WAIT_L(0); PG8_BAR; PG8_MMA(0, 0, At, B0); PG8_MMA(0, 1, At, B1); PG8_BAR; PG8_SCHED;
            PG8_LDA(At, 0, 1); PG8_STAGE(PG8_SB(0, 0), b2, voffB); PG8_STAGE(PG8_SB(0, 1), b2 + hstepB, voffB); PG8_STAGE(PG8_SA(0, 0), a2, voffA);
            PG8_WAIT_V(8); PG8_WAIT_L(0); PG8_BAR; PG8_MMA(1, 0, At, B0); PG8_MMA(1, 1, At, B1); PG8_BAR; PG8_SCHED;
            PG8_LDB(B0, 1, 0); PG8_LDB(B1, 1, 1); PG8_SCHED; PG8_LDA(At, 1, 0); PG8_STAGE(PG8_SA(0, 1), a2 + hstepA, voffA);
            PG8_WAIT_V(8); PG8_WAIT_L(0); PG8_BAR; PG8_MMA(0, 0, At, B0); PG8_MMA(0, 1, At, B1); PG8_BAR; PG8_SCHED;
            PG8_LDA(At, 1, 1); PG8_STAGE(PG8_SB(1, 0), b3, voffB); PG8_STAGE(PG8_SB(1, 1), b3 + hstepB, voffB); PG8_STAGE(PG8_SA(1, 0), a3, voffA);
            PG8_WAIT_V(8); PG8_WAIT_L(0); PG8_BAR; PG8_MMA(1, 0, At, B0); PG8_MMA(1, 1, At, B1); PG8_BAR; PG8_SCHED;
        }
        if constexpr (ALIGN_EPI) { if (wr == 0) PG8_BAR; }
        E(acc, cur, wr, wc, fr, fq);
        if (!has_next) break;
#pragma unroll
        for (int a = 0; a < 2; ++a)
#pragma unroll
            for (int b = 0; b < 2; ++b)
#pragma unroll
                for (int m = 0; m < 4; ++m)
#pragma unroll
                    for (int n = 0; n < 2; ++n) acc[a][b][m][n] = (f32x4){0.f, 0.f, 0.f, 0.f};
        cur = nxt; cA = nA; cB = nB; ++ui;
        if constexpr (ALIGN_EPI) { if (wr == 1) PG8_BAR; }
    }
    PG8_WAIT_V(0);
    if constexpr (!ALIGN_EPI) { if (wr == 0) PG8_BAR; }
    PG8_BAR;
#undef PG8_SA
#undef PG8_SB
#undef PG8_STAGE
#undef PG8_LDA
#undef PG8_LDB
#undef PG8_MMA
#undef PG8_WAIT_V
#undef PG8_WAIT_L
#undef PG8_BAR
#undef PG8_SCHED
}
}

namespace att {
#define SBAR() __builtin_amdgcn_sched_barrier(0)
__device__ __forceinline__ int v_st(int k, int c) { const int kk = (k & ~0xC) | ((k & 4) << 1) | ((k & 8) >> 1); return ((kk >> 3) * 4 + (c >> 5)) * 512 + ((kk & 7) * 32 + (c & 31)) * 2; }
__device__ __forceinline__ int v_rd_base(int lane) { return ((lane & 3) << 3) | (((lane >> 2) & 3) << 6) | (((lane >> 4) & 1) << 5) | (((lane >> 5) & 1) << 8); }
constexpr int v_rd_off(int d0, int ks, int half) { return d0 * 512 + ks * 4096 + half * 2048; }
__device__ __forceinline__ int crow(int r, int hi) { return (r & 3) + 8 * (r >> 2) + 4 * hi; }
constexpr int SHM_V = 64 * 128 * 2;
__device__ __forceinline__ void mask_tile(f32x16& p0, f32x16& p1, int dq) {
    const float NEG = -__builtin_inff();
#pragma unroll
    for (int r = 0; r < 16; ++r) { const int c = (r & 3) + 8 * (r >> 2); if (dq - c < 0) p0[r] = NEG; if (dq - c - 32 < 0) p1[r] = NEG; }
}
__device__ __forceinline__ void partialSM(f32x16& p0, f32x16& p1, float& m_reg, float& mn, float& alpha, const float C2  ) {
    float pmax = p0[0];
#pragma unroll
    for (int r = 1; r < 16; ++r) pmax = fmaxf(pmax, p0[r]);
#pragma unroll
    for (int r = 0; r < 16; ++r) pmax = fmaxf(pmax, p1[r]);
    { auto rr = __builtin_amdgcn_permlane32_swap(__float_as_uint(pmax), __float_as_uint(pmax), false, false); pmax = fmaxf(__uint_as_float(rr[0]), __uint_as_float(rr[1])); }
    if (__builtin_expect(__all((pmax - m_reg) * C2 <= 11.5f), 1)) { mn = m_reg; alpha = 1.f; }
    else { mn = fmaxf(m_reg, pmax); alpha = __builtin_amdgcn_exp2f((m_reg - mn) * C2); m_reg = mn; }
    const float mnL = -mn * C2;
#pragma unroll
    for (int r = 0; r < 16; ++r) p0[r] = fmaf(p0[r], C2, mnL);
#pragma unroll
    for (int r = 0; r < 16; ++r) p1[r] = fmaf(p1[r], C2, mnL);
#pragma unroll
    for (int r = 0; r < 16; ++r) p0[r] = __builtin_amdgcn_exp2f(p0[r]);
}
__device__ __forceinline__ void finishSM(f32x16& p0, f32x16& p1, float alpha, float& l_reg, bf16x8& pa0, bf16x8& pa1, bf16x8& pa2, bf16x8& pa3) {
#pragma unroll
    for (int r = 0; r < 16; ++r) p1[r] = __builtin_amdgcn_exp2f(p1[r]);
    float ps = 0;
#pragma unroll
    for (int r = 0; r < 16; ++r) ps += p0[r];
#pragma unroll
    for (int r = 0; r < 16; ++r) ps += p1[r];
    { auto rr = __builtin_amdgcn_permlane32_swap(__float_as_uint(ps), __float_as_uint(ps), false, false); ps = __uint_as_float(rr[0]) + __uint_as_float(rr[1]); }
    l_reg = l_reg * alpha + ps;
#define PK4(P, B_, OUT) do { unsigned a0 = cvt_pk_bf16(P[B_+0], P[B_+1]), a1 = cvt_pk_bf16(P[B_+2], P[B_+3]); \
        unsigned b0 = cvt_pk_bf16(P[B_+4], P[B_+5]), b1 = cvt_pk_bf16(P[B_+6], P[B_+7]); \
        auto r0 = __builtin_amdgcn_permlane32_swap(a0, b0, false, false); auto r1 = __builtin_amdgcn_permlane32_swap(a1, b1, false, false); \
        u32x4 w = {r0[0], r1[0], r0[1], r1[1]}; OUT = *reinterpret_cast<bf16x8*>(&w); } while (0)
    PK4(p0, 0, pa0); PK4(p0, 8, pa1); PK4(p1, 0, pa2); PK4(p1, 8, pa3);
#undef PK4
}
template <int KB, int DQK>
__device__ __forceinline__ void qkt(f32x16& p0, f32x16& p1, const LAS unsigned char* K_lds, int r32, int hi, const bf16x8* qr) {
    constexpr int KROW = DQK * 2, SHM_K = 64 * KROW;
    p0 = f32x16{}; p1 = f32x16{};
    const int sw = (r32 & 7) << 4;
#pragma unroll
    for (int d0 = 0; d0 < DQK / 16; ++d0) { const LAS unsigned char* a = K_lds + KB * SHM_K + r32 * KROW + ((d0 * 32 + hi * 16) ^ sw);
        const bf16x8 b0 = *(const LAS bf16x8*)a, b1 = *(const LAS bf16x8*)(a + 32 * KROW);
        p0 = __builtin_amdgcn_mfma_f32_32x32x16_bf16(b0, qr[d0], p0, 0, 0, 0);
        p1 = __builtin_amdgcn_mfma_f32_32x32x16_bf16(b1, qr[d0], p1, 0, 0, 0); }
}
template <int VB>
__device__ __forceinline__ void pv_tile(f32x16* o, int vb0, bf16x8 pa0, bf16x8 pa1, bf16x8 pa2, bf16x8 pa3) {
#define TRRD(dst, off) asm volatile("ds_read_b64_tr_b16 %0, %1 offset:%2" : "=&v"(dst) : "v"(vb0), "i"(off) : "memory")
#define PV_D0(d0) do { s16x4 l0, l1, l2, l3, h0, h1, h2, h3; constexpr int b_ = VB * SHM_V + v_rd_off(d0, 0, 0); \
        TRRD(l0, b_); TRRD(h0, b_ + 2048); TRRD(l1, b_ + 4096); TRRD(h1, b_ + 6144); TRRD(l2, b_ + 8192); TRRD(h2, b_ + 10240); TRRD(l3, b_ + 12288); TRRD(h3, b_ + 14336); \
        asm volatile("s_waitcnt lgkmcnt(0)" ::: "memory"); SBAR(); \
        o[d0] = __builtin_amdgcn_mfma_f32_32x32x16_bf16(pa0, (bf16x8){l0[0], l0[1], l0[2], l0[3], h0[0], h0[1], h0[2], h0[3]}, o[d0], 0, 0, 0); \
        o[d0] = __builtin_amdgcn_mfma_f32_32x32x16_bf16(pa1, (bf16x8){l1[0], l1[1], l1[2], l1[3], h1[0], h1[1], h1[2], h1[3]}, o[d0], 0, 0, 0); \
        o[d0] = __builtin_amdgcn_mfma_f32_32x32x16_bf16(pa2, (bf16x8){l2[0], l2[1], l2[2], l2[3], h2[0], h2[1], h2[2], h2[3]}, o[d0], 0, 0, 0); \
        o[d0] = __builtin_amdgcn_mfma_f32_32x32x16_bf16(pa3, (bf16x8){l3[0], l3[1], l3[2], l3[3], h3[0], h3[1], h3[2], h3[3]}, o[d0], 0, 0, 0); } while (0)
    PV_D0(0); PV_D0(1); PV_D0(2); PV_D0(3);
#undef PV_D0
#undef TRRD
}
template <int DQK, bool CAUSAL>
__device__ __forceinline__ void attn_unit(LAS unsigned char* lds, const bf16_t* Q, int ldq, const bf16_t* Kn, int ldk, const bf16_t* Kr, int ldkr, const bf16_t* V, int ldv,
                                          bf16_t* O, int ldo, int q0, int NT, float C2) {
    constexpr int KROW = DQK * 2, SHM_K = 64 * KROW, ND = DQK / 16;
    int tid = threadIdx.x; asm volatile("" : "+v"(tid));
    const int wid = __builtin_amdgcn_readfirstlane(tid >> 6), lane = tid & 63, r32 = lane & 31, hi = lane >> 5;
    LAS unsigned char* V_lds = lds; LAS unsigned char* K_lds = lds + 2 * SHM_V;
    LAS float* ws = (LAS float*)(lds + 2 * SHM_V + 2 * SHM_K) + wid * 64; LAS float* li_l = ws; LAS float* al_l = ws + 32;
    bf16x8 qr[ND];
#pragma unroll
    for (int d0 = 0; d0 < ND; ++d0) qr[d0] = *(const bf16x8*)(Q + (size_t)(wid * 32 + r32) * ldq + d0 * 16 + hi * 8);
    float m_reg = -1e30f, l_reg = 0.f; f32x16 o[4] = {};
    const int sr = tid >> 4, sc = (tid & 15) * 8, vst0 = v_st(sr, sc), vst1 = v_st(32 + sr, sc);
    const int kws0 = sr * KROW + ((sc * 2) ^ ((sr & 7) << 4)), kws1 = kws0 + 32 * KROW;
    const int rr_ = tid >> 3, rc_ = (tid & 7) * 8, kwsr = rr_ * KROW + ((256 + rc_ * 2) ^ ((rr_ & 7) << 4));
    const int vb0 = (int)(unsigned)(uintptr_t)V_lds + v_rd_base(lane);
    const int qlo = q0 + wid * 32, qm = qlo + r32 - 4 * hi;
    bf16x8 st_v0, st_v1, st_k0, st_k1, st_kr;
#define ATT_LOAD(t) do { const int kb_ = (t) * 64; \
        st_v0 = *(const bf16x8*)(V + (size_t)(kb_ + sr) * ldv + sc); st_v1 = *(const bf16x8*)(V + (size_t)(kb_ + 32 + sr) * ldv + sc); \
        st_k0 = *(const bf16x8*)(Kn + (size_t)(kb_ + sr) * ldk + sc); st_k1 = *(const bf16x8*)(Kn + (size_t)(kb_ + 32 + sr) * ldk + sc); \
        if constexpr (DQK == 192) st_kr = *(const bf16x8*)(Kr + (size_t)(kb_ + rr_) * ldkr + rc_); } while (0)
#define ATT_WRITE(BUF) do { *(LAS bf16x8*)(V_lds + (BUF) * SHM_V + vst0) = st_v0; *(LAS bf16x8*)(V_lds + (BUF) * SHM_V + vst1) = st_v1; \
        *(LAS bf16x8*)(K_lds + (BUF) * SHM_K + kws0) = st_k0; *(LAS bf16x8*)(K_lds + (BUF) * SHM_K + kws1) = st_k1; \
        if constexpr (DQK == 192) *(LAS bf16x8*)(K_lds + (BUF) * SHM_K + kwsr) = st_kr; } while (0)
#define ATT_STEP(BUF, t) do { \
        ATT_WRITE(BUF); __syncthreads(); \
        if ((t) + 1 < NT) ATT_LOAD((t) + 1); \
        f32x16 p0, p1; qkt<BUF, DQK>(p0, p1, K_lds, r32, hi, qr); \
        if constexpr (CAUSAL) { const int kb_ = (t) * 64; if (kb_ + 63 > qlo) mask_tile(p0, p1, qm - kb_); } \
        float mn, alpha; partialSM(p0, p1, m_reg, mn, alpha, C2); \
        if (__any(alpha < 1.f)) { if (hi == 0) al_l[r32] = alpha; asm volatile("s_waitcnt lgkmcnt(0)" ::: "memory"); \
            _Pragma("unroll") for (int d_ = 0; d_ < 4; ++d_) _Pragma("unroll") for (int r = 0; r < 16; ++r) o[d_][r] *= al_l[crow(r, hi)]; } \
        bf16x8 pa0, pa1, pa2, pa3; finishSM(p0, p1, alpha, l_reg, pa0, pa1, pa2, pa3); SBAR(); \
        pv_tile<BUF>(o, vb0, pa0, pa1, pa2, pa3); } while (0)
    ATT_LOAD(0);
    for (int t = 0; t < NT; t += 2) { ATT_STEP(0, t); ATT_STEP(1, t + 1); }
#undef ATT_LOAD
#undef ATT_WRITE
#undef ATT_STEP
    if (hi == 0) li_l[r32] = l_reg; asm volatile("s_waitcnt lgkmcnt(0)" ::: "memory");
    float rli[16];
#pragma unroll
    for (int r = 0; r < 16; ++r) rli[r] = __builtin_amdgcn_rcpf(li_l[crow(r, hi)]);
    bf16_t* Ow = O + (size_t)(wid * 32) * ldo;
#pragma unroll
    for (int r = 0; r < 16; ++r) { const int orow = crow(r, hi);
#pragma unroll
        for (int d0 = 0; d0 < 4; ++d0) { const float v = o[d0][r] * rli[r]; const float vn = __shfl_xor(v, 1);
            if ((r32 & 1) == 0) *(unsigned*)(Ow + (size_t)orow * ldo + d0 * 32 + r32) = cvt_pk_bf16(v, vn); } }
    __syncthreads();
}
#undef SBAR
__constant__ unsigned char MLA_BINS[16][8] = {
    {0x0F, 0x08, 0xFF, 0xFF, 0xFF, 0xFF, 0xFF, 0xFF}, {0x1F, 0x18, 0x00, 0xFF, 0xFF, 0xFF, 0xFF, 0xFF}, {0x2F, 0x09, 0xFF, 0xFF, 0xFF, 0xFF, 0xFF, 0xFF}, {0x0E, 0x19, 0xFF, 0xFF, 0xFF, 0xFF, 0xFF, 0xFF},
    {0x1E, 0x29, 0x10, 0xFF, 0xFF, 0xFF, 0xFF, 0xFF}, {0x2E, 0x0A, 0xFF, 0xFF, 0xFF, 0xFF, 0xFF, 0xFF}, {0x0D, 0x1A, 0xFF, 0xFF, 0xFF, 0xFF, 0xFF, 0xFF}, {0x1D, 0x2A, 0x20, 0xFF, 0xFF, 0xFF, 0xFF, 0xFF},
    {0x2D, 0x0B, 0xFF, 0xFF, 0xFF, 0xFF, 0xFF, 0xFF}, {0x0C, 0x1B, 0xFF, 0xFF, 0xFF, 0xFF, 0xFF, 0xFF}, {0x1C, 0x2B, 0xFF, 0xFF, 0xFF, 0xFF, 0xFF, 0xFF}, {0x2C, 0x28, 0x03, 0xFF, 0xFF, 0xFF, 0xFF, 0xFF},
    {0x07, 0x17, 0x06, 0x01, 0xFF, 0xFF, 0xFF, 0xFF}, {0x27, 0x16, 0x05, 0x13, 0xFF, 0xFF, 0xFF, 0xFF}, {0x26, 0x15, 0x25, 0x23, 0x11, 0xFF, 0xFF, 0xFF}, {0x04, 0x14, 0x24, 0x02, 0x12, 0x22, 0x21, 0xFF}};
}

constexpr size_t MiB = 1u << 20;
constexpr size_t al256(size_t x) { return (x + 255) & ~(size_t)255; }
constexpr size_t WS_CTL = 0, CTL_ZERO_BYTES = 64 * 1024;
constexpr size_t SZ_GU = (size_t)2 * DFF * DM * 2, SZ_DN = (size_t)DM * DFF * 2;
constexpr size_t WS_GU = 1 * MiB, WS_DN = WS_GU + 8 * SZ_GU, WS_WOUT = WS_DN + 8 * SZ_DN;
constexpr size_t WS_MEMW = WS_WOUT + (size_t)4 * DM * DM * 2;
constexpr size_t WS_AIN = WS_MEMW + (size_t)4 * 1024 * DM * 2;
constexpr size_t WS_GLU = WS_AIN + (size_t)2 * DM * DM * 2;
constexpr size_t WS_BIN = WS_GLU + (size_t)2 * TOKW * TOKW * 2;
constexpr size_t WS_UQ = WS_BIN + (size_t)2 * 1024 * DM * 2;
constexpr size_t WS_DKV = WS_UQ + (size_t)2 * NH * DQKH * QRANK * 2;
constexpr size_t WS_UKV = WS_DKV + (size_t)768 * DM * 2;
constexpr size_t WS_TF = WS_UKV + (size_t)3072 * KVRANK * 2;
constexpr size_t WS_GM = WS_TF + (size_t)2 * S5G * 256 * 384 * 2;
constexpr size_t WS_L16 = WS_GM + (size_t)2 * S5G * 256 * 256 * 2;
constexpr size_t WS_COS = WS_L16 + (size_t)2 * S5G * S5P * 2 * 4, WS_SIN = WS_COS + (size_t)M * 32 * 4;
constexpr size_t WS_MEMN = WS_SIN + (size_t)M * 32 * 4;
constexpr size_t WS_MKV = WS_MEMN + (size_t)4 * 1024 * DM * 2;
constexpr size_t WS_HB = WS_MKV + (size_t)4 * 1024 * 1024 * 2;
constexpr size_t WS_FB = WS_HB + (size_t)M * DM * 2;
constexpr size_t WS_CAT = WS_FB + (size_t)M * DM * 2;
constexpr size_t WS_QMEM = WS_CAT + (size_t)M * DM * 2;
constexpr size_t WS_HKV = WS_QMEM + (size_t)M * MEMW * 2;
constexpr size_t WS_CKV = WS_HKV + (size_t)M * DM * 2;
constexpr size_t WS_SSQ = WS_CKV + (size_t)M * KVRANK * 2;
constexpr size_t WS_KR = WS_SSQ + (size_t)2 * M * 8 * 4;
constexpr size_t WS_KN = WS_KR + (size_t)M * DROPE * 2, WS_VV = WS_KN + (size_t)M * TOKW * 2;
constexpr size_t WS_ACT = WS_VV + (size_t)M * TOKW * 2;
constexpr size_t WS_UH = WS_ACT;
constexpr size_t WS_SEND = WS_UH + (size_t)S5G * NCHUNK * 384 * 2;
constexpr size_t WS_Y = WS_SEND + (size_t)S5G * NCHUNK * 128 * 4;
constexpr size_t WS_CQ = WS_ACT, WS_Q = WS_CQ + (size_t)M * QRANK * 2;
constexpr size_t WS_END = WS_ACT + (size_t)M * DFF * 2;
static_assert(WS_Y + (size_t)S5G * NCHUNK * 256 * 2 <= WS_END && WS_Q + (size_t)M * NH * DQKH * 2 <= WS_END, "mixer scratch fits the activation buffer");
static_assert(WS_END <= (size_t)1408 * MiB, "d_ws map");

constexpr int NWAVES = 8;
constexpr int RING_OFF = 0, RING_BYTES = 131072;
constexpr int LDSCTL_OFF = RING_BYTES, MISC_OFF = LDSCTL_OFF + 320;
constexpr int LDS_BYTES = 147456;

typedef GAS unsigned gu32;
#define RLX_AGENT __ATOMIC_RELAXED, __HIP_MEMORY_SCOPE_AGENT
#define LDS_WAIT() asm volatile("s_waitcnt lgkmcnt(0)" ::: "memory")
#define VM_WAIT() asm volatile("s_waitcnt vmcnt(0)" ::: "memory")
__device__ __forceinline__ unsigned f2bf(float f) { unsigned u = __builtin_bit_cast(unsigned, f); return (u + 0x7fffu + ((u >> 16) & 1u)) >> 16; }
__device__ __forceinline__ unsigned pk2(float lo, float hi) { return f2bf(lo) | (f2bf(hi) << 16); }

#define XB_TMO      128
#define XB_XCNT(j)  (256  + 64 * (j))
#define XB_XSUB(j)  (1280 + 64 * (j))
#define XB_XGEN(j)  (2304 + 64 * (j))
#define XB_TOP      3328
#define XB_TOPGEN   3392
#define XCD_BAR_WORDS 3456
#define XB_SPIN_CAP (1u << 18)
__device__ __forceinline__ unsigned xb_ld(unsigned* p)              { return __hip_atomic_load(p, __ATOMIC_RELAXED, __HIP_MEMORY_SCOPE_AGENT); }
__device__ __forceinline__ unsigned xb_add(unsigned* p, unsigned v) { return __hip_atomic_fetch_add(p, v, __ATOMIC_RELAXED, __HIP_MEMORY_SCOPE_AGENT); }
__device__ __forceinline__ unsigned xb_xcc_id() { return (unsigned)__builtin_amdgcn_s_getreg((3 << 11) | 20) & 0xFu; }
#define XB_SPIN(cond, bar) do { unsigned _sp = 0; while (cond) { __builtin_amdgcn_s_sleep(1); \
    if ((++_sp & 255u) == 0u) { if (xb_ld(&(bar)[XB_TMO])) break; if (_sp > XB_SPIN_CAP) { atomicAdd(&(bar)[XB_TMO], 1u); break; } } } } while (0)
struct XcdBarrier { unsigned* bar; unsigned x; volatile LAS unsigned* st; };
__device__ __forceinline__ XcdBarrier xcd_barrier_post(unsigned* bar, volatile LAS unsigned* st) {
    XcdBarrier b; b.bar = bar; b.x = xb_xcc_id(); b.st = st;
    if (threadIdx.x == 0) (void)xb_add(&bar[XB_XCNT(b.x)], 1u);
    return b;
}
__device__ __forceinline__ void xcd_barrier_complete(unsigned* bar, unsigned x, unsigned& nloc, unsigned& nx) {
    const unsigned G = gridDim.x * gridDim.y * gridDim.z;
    unsigned sum, cnt, mine, sp = 0u;
    for (;;) {
        sum = 0u; cnt = 0u; mine = 0u;
#pragma unroll
        for (unsigned j = 0; j < 16; ++j) { const unsigned c = xb_ld(&bar[XB_XCNT(j)]); sum += c; cnt += (c > 0u) ? 1u : 0u; mine = (j == x) ? c : mine; }
        if (sum == G) break;
        __builtin_amdgcn_s_sleep(1);
        if ((++sp & 255u) == 0u) { if (xb_ld(&bar[XB_TMO])) break; if (sp > XB_SPIN_CAP) { atomicAdd(&bar[XB_TMO], 1u); break; } }
    }
    nloc = mine > 0u ? mine : 1u; nx = cnt > 0u ? cnt : 1u;
}
__device__ __forceinline__ void xcd_barrier(const XcdBarrier& b) {
    asm volatile("s_waitcnt vmcnt(0)" ::: "memory");
    __syncthreads();
    if (threadIdx.x == 0) {
        unsigned* bar = b.bar;
        __builtin_amdgcn_s_waitcnt(0);
        unsigned nloc = b.st[0], nx = b.st[1];
        if (nloc == 0u) { xcd_barrier_complete(bar, b.x, nloc, nx); b.st[0] = nloc; b.st[1] = nx; }
        const unsigned old = xb_add(&bar[XB_XSUB(b.x)], 1u);
        const unsigned gen = old / nloc;
        if (old + 1u == (gen + 1u) * nloc) {
            __builtin_amdgcn_fence(__ATOMIC_RELEASE, "agent");
            asm volatile("s_waitcnt vmcnt(0)" ::: "memory");
            const unsigned og = xb_add(&bar[XB_TOP], 1u);
            const unsigned tg = og / nx;
            if (og + 1u == (tg + 1u) * nx) xb_add(&bar[XB_TOPGEN], 1u);
            else XB_SPIN(xb_ld(&bar[XB_TOPGEN]) == tg, bar);
            __builtin_amdgcn_fence(__ATOMIC_ACQUIRE, "agent");
            xb_add(&bar[XB_XGEN(b.x)], 1u);
            asm volatile("s_waitcnt vmcnt(0)" ::: "memory");
        } else {
            XB_SPIN(xb_ld(&bar[XB_XGEN(b.x)]) == gen, bar);
            __builtin_amdgcn_fence(__ATOMIC_ACQUIRE, "agent");
            asm volatile("s_waitcnt vmcnt(0)" ::: "memory");
        }
    }
    __syncthreads();
}

struct Args { const float* in[30]; float* out; unsigned char* wsp; int ph_lo, ph_hi; };
struct Frame {
    LAS unsigned char* lds;
    int tid, lane, wave, vcu, G;
};
__device__ __forceinline__ float wave_sum(float v) {
#pragma unroll
    for (int o = 1; o < 64; o <<= 1) v += __shfl_xor(v, o);
    return v;
}
__device__ __forceinline__ void sincos_d(double a, float& s, float& c) {
    const double n = __builtin_rint(a * 0.63661977236758134308); const double r = __builtin_fma(-n, 1.57079632679489661923, a) - n * 6.123233995736766e-17;
    const double r2 = r * r;
    const double sp = r * (1.0 + r2 * (-1.0 / 6 + r2 * (1.0 / 120 + r2 * (-1.0 / 5040 + r2 * (1.0 / 362880 + r2 * (-1.0 / 39916800 + r2 * (1.0 / 6227020800.0)))))));
    const double cp = 1.0 + r2 * (-0.5 + r2 * (1.0 / 24 + r2 * (-1.0 / 720 + r2 * (1.0 / 40320 + r2 * (-1.0 / 3628800 + r2 * (1.0 / 479001600.0 + r2 * (-1.0 / 87178291200.0)))))));
    const int q = (int)((long long)n & 3);
    const double ss = (q & 1) ? cp : sp, cc = (q & 1) ? sp : cp;
    s = (float)((q & 2) ? -ss : ss); c = (float)(((q + 1) & 2) ? -cc : cc);
}

enum { MAP_PLAIN = 0, MAP_GATE = 1, MAP_UP = 2, MAP_ROPE64 = 3, MAP_UQ = 4 };
__device__ __forceinline__ int rope_pos(int d) { const int half = d >> 5, i = d & 31; return 8 * (i >> 2) + 4 * half + (i & 3); }
__device__ __forceinline__ int map_row(int mode, int n) {
    if (mode == MAP_GATE) return (n >> 7) * 256 + (n & 127);
    if (mode == MAP_UP) return (n >> 7) * 256 + 128 + (n & 127);
    if (mode == MAP_ROPE64) return rope_pos(n);
    if (mode == MAP_UQ) { const int h = n / DQKH, j = n - h * DQKH; return j < DNOPE ? n : h * DQKH + DNOPE + rope_pos(j - DNOPE); }
    return n;
}
__device__ __forceinline__ void transpose_item(const float* W, int K, int N, bf16_t* WT, int ldo, int row_off, int mode, const float* kgain, LAS float* scr, int item, int lane) {
    const int nblk = N / 32, kb = item / nblk, nb = item % nblk, k0 = 64 * kb, n0 = 32 * nb;
#pragma unroll 8
    for (int i = 0; i < 32; ++i) { const int kk = 2 * i + (lane >> 5); scr[kk * 33 + (lane & 31)] = W[(size_t)(k0 + kk) * N + n0 + (lane & 31)]; }
    LDS_WAIT(); asm volatile("" ::: "memory");
    const int c = lane & 7;
    float gk[8];
#pragma unroll
    for (int e = 0; e < 8; ++e) gk[e] = kgain ? kgain[k0 + 8 * c + e] : 1.0f;
#pragma unroll
    for (int j = 0; j < 4; ++j) { const int n = (lane >> 3) + 8 * j; const LAS float* s = scr + (8 * c) * 33 + n;
        u32x4 o; o.x = pk2(s[0 * 33] * gk[0], s[1 * 33] * gk[1]); o.y = pk2(s[2 * 33] * gk[2], s[3 * 33] * gk[3]); o.z = pk2(s[4 * 33] * gk[4], s[5 * 33] * gk[5]); o.w = pk2(s[6 * 33] * gk[6], s[7 * 33] * gk[7]);
        *(GAS u32x4*)(WT + (size_t)(row_off + map_row(mode, n0 + n)) * ldo + k0 + 8 * c) = o; }
    LDS_WAIT(); asm volatile("" ::: "memory");
}
__device__ __forceinline__ void rms_row_to_bf16(const float* xrow, const float* gain, bf16_t* orow, int lane) {
    f32x4 v[8]; float s = 0.f;
#pragma unroll
    for (int j = 0; j < 4; ++j) { v[2 * j] = *(const f32x4*)(xrow + j * 512 + lane * 8); v[2 * j + 1] = *(const f32x4*)(xrow + j * 512 + lane * 8 + 4); }
#pragma unroll
    for (int j = 0; j < 8; ++j) s += (v[j][0] * v[j][0] + v[j][1] * v[j][1]) + (v[j][2] * v[j][2] + v[j][3] * v[j][3]);
    const float rstd = 1.0f / sqrtf(wave_sum(s) * (1.0f / DM) + EPS);
#pragma unroll
    for (int j = 0; j < 4; ++j) { const f32x4 g0 = *(const f32x4*)(gain + j * 512 + lane * 8), g1 = *(const f32x4*)(gain + j * 512 + lane * 8 + 4);
        *(u32x4*)(orow + j * 512 + lane * 8) = pack8(v[2 * j] * rstd * g0, v[2 * j + 1] * rstd * g1); }
}
__device__ __forceinline__ void s5_precompute_item(const Args& a, unsigned char* ws, LAS unsigned char* lds, int la, int g, int tid) {
    LAS float* lp_re = (LAS float*)lds;
    LAS float* lp_im = lp_re + 17 * 64;
    LAS float* bb_re = lp_im + 17 * 64;
    LAS float* bb_im = bb_re + 64 * 16;
    LAS float* cc_re = bb_im + 64 * 16;
    LAS float* cc_im = cc_re + 16 * 64;
    LAS float* km = cc_im + 16 * 64;
    LAS float* dd = km + 16 * 256;
    const float* lam_re = a.in[11] + (size_t)(la * S5G + g) * S5P; const float* lam_im = a.in[12] + (size_t)(la * S5G + g) * S5P;
    const float* b_re = a.in[13] + (size_t)(la * S5G + g) * S5P * S5C; const float* b_im = a.in[14] + (size_t)(la * S5G + g) * S5P * S5C;
    const float* c_re = a.in[15] + (size_t)(la * S5G + g) * S5C * S5P; const float* c_im = a.in[16] + (size_t)(la * S5G + g) * S5C * S5P;
    const float* dvec = a.in[17] + (size_t)la * TOKW + g * S5C;
    const float dt = expf(a.in[18][la * S5G + g]);
    if (tid < 64) { const int p = tid; const float lr = lam_re[p], li = lam_im[p];
        const double ad = (double)lr * (double)dt, bd = (double)li * (double)dt;
        for (int j = 0; j <= 16; ++j) { float s, c; sincos_d(bd * j, s, c); const float mag = expf((float)(ad * j)); lp_re[j * 64 + p] = mag * c; lp_im[j * 64 + p] = mag * s; }
        float sb, cb, sh, ch; sincos_d(bd, sb, cb); sincos_d(0.5 * bd, sh, ch); (void)ch;
        const float af = (float)ad; const float em1 = af * (1.f + af * (0.5f + af * (1.f / 6 + af * (1.f / 24 + af * (1.f / 120 + af * (1.f / 720))))));
        const float xr = em1 * cb - 2.f * sh * sh, xi = (em1 + 1.f) * sb;
        const float den = 1.f / (lr * lr + li * li); const float cr = (xr * lr + xi * li) * den, ci = (xi * lr - xr * li) * den;
        for (int c = 0; c < 16; ++c) { const float br = b_re[p * 16 + c], bi = b_im[p * 16 + c]; bb_re[p * 16 + c] = cr * br - ci * bi; bb_im[p * 16 + c] = cr * bi + ci * br; }
        float* l16 = (float*)(ws + WS_L16) + ((size_t)(la * S5G + g) * S5P + p) * 2; l16[0] = lp_re[16 * 64 + p]; l16[1] = lp_im[16 * 64 + p];
    }
    for (int i = tid; i < 1024; i += 512) { cc_re[i] = c_re[i]; cc_im[i] = c_im[i]; }
    if (tid < 16) dd[tid] = dvec[tid];
    __syncthreads();
    for (int e = tid; e < 4096; e += 512) { const int j = e >> 8, co = (e >> 4) & 15, ci = e & 15; float s = 0.f;
        for (int p = 0; p < 64; ++p) { const float zr = cc_re[co * 64 + p] * lp_re[j * 64 + p] - cc_im[co * 64 + p] * lp_im[j * 64 + p], zi = cc_re[co * 64 + p] * lp_im[j * 64 + p] + cc_im[co * 64 + p] * lp_re[j * 64 + p];
            s += zr * bb_re[p * 16 + ci] - zi * bb_im[p * 16 + ci]; }
        km[e] = s; }
    __syncthreads();
    bf16_t* TF = (bf16_t*)(ws + WS_TF) + ((size_t)(la * S5G + g) * 256) * 384;
    for (int pc = tid; pc < 256 * 48; pc += 512) { const int n = pc / 48, k0 = (pc % 48) * 8, to = n >> 4, co = n & 15; float v[8];
        if (k0 < 256) { const int ti = k0 >> 4, ci0 = k0 & 15, j = to - ti;
#pragma unroll
            for (int e = 0; e < 8; ++e) v[e] = j >= 0 ? km[(j * 16 + co) * 16 + ci0 + e] + ((j == 0 && ci0 + e == co) ? dd[co] : 0.f) : 0.f; }
        else { const int im = k0 >= 320, p0 = (k0 - 256) & 63;
#pragma unroll
            for (int e = 0; e < 8; ++e) { const int p = p0 + e; const float cr = cc_re[co * 64 + p], ci = cc_im[co * 64 + p], lr = lp_re[(to + 1) * 64 + p], li = lp_im[(to + 1) * 64 + p];
                v[e] = im ? -(cr * li + ci * lr) : (cr * lr - ci * li); } }
        u32x4 o; o.x = pk2(v[0], v[1]); o.y = pk2(v[2], v[3]); o.z = pk2(v[4], v[5]); o.w = pk2(v[6], v[7]);
        *(GAS u32x4*)(TF + (size_t)n * 384 + k0) = o; }
    bf16_t* GMo = (bf16_t*)(ws + WS_GM) + ((size_t)(la * S5G + g) * 256) * 256;
    for (int pc = tid; pc < 256 * 32; pc += 512) { const int q = pc >> 5, k0 = (pc & 31) * 8, t = k0 >> 4, c0 = k0 & 15; float v[8];
        if (q < 128) { const int p = q & 63, im = q >> 6; const float lr = lp_re[(15 - t) * 64 + p], li = lp_im[(15 - t) * 64 + p];
#pragma unroll
            for (int e = 0; e < 8; ++e) { const float br = bb_re[p * 16 + c0 + e], bi = bb_im[p * 16 + c0 + e]; v[e] = im ? (lr * bi + li * br) : (lr * br - li * bi); } }
        else {
#pragma unroll
            for (int e = 0; e < 8; ++e) v[e] = 0.f; }
        u32x4 o; o.x = pk2(v[0], v[1]); o.y = pk2(v[2], v[3]); o.z = pk2(v[4], v[5]); o.w = pk2(v[6], v[7]);
        *(GAS u32x4*)(GMo + (size_t)q * 256 + k0) = o; }
    __syncthreads();
}
__device__ __forceinline__ void p0_prologue(const Args& a, Frame& F) {
    unsigned char* ws = a.wsp;
    for (int it = F.vcu; it < NA * S5G; it += F.G) s5_precompute_item(a, ws, F.lds, it / S5G, it % S5G, F.tid);
    LAS float* scr = (LAS float*)(F.lds + RING_OFF + F.wave * 16384);
    const int gw = F.vcu * NWAVES + F.wave, NGW = F.G * NWAVES;
    constexpr int I_FF = (DM / 64) * (DFF / 32), I_DN = (DFF / 64) * (DM / 32), I_WO = (DM / 64) * (DM / 32), I_MK = (DM / 64) * (1024 / 32), I_AI = I_WO, I_GL = (TOKW / 64) * (TOKW / 32),
                  I_BI = I_MK, I_UQ = (QRANK / 64) * (NH * DQKH / 32), I_DK = (DM / 64) * (KVRANK / 32), I_KR = (DM / 64) * (DROPE / 32), I_UK = (KVRANK / 64) * (TOKW / 32);
    constexpr int NITEMS = 8 * I_FF * 2 + 8 * I_DN + 4 * I_WO + 4 * I_MK + 2 * I_AI + 2 * I_GL + 2 * I_BI + 2 * I_UQ + I_DK + I_KR + 2 * I_UK;
    for (int it = gw; it < NITEMS; it += NGW) {
        int r = it;
        if (r < 8 * I_FF) { const int f = r / I_FF; transpose_item(a.in[4] + (size_t)f * DM * DFF, DM, DFF, (bf16_t*)(ws + WS_GU + f * SZ_GU), DM, 0, MAP_GATE, nullptr, scr, r % I_FF, F.lane); continue; } r -= 8 * I_FF;
        if (r < 8 * I_FF) { const int f = r / I_FF; transpose_item(a.in[5] + (size_t)f * DM * DFF, DM, DFF, (bf16_t*)(ws + WS_GU + f * SZ_GU), DM, 0, MAP_UP, nullptr, scr, r % I_FF, F.lane); continue; } r -= 8 * I_FF;
        if (r < 8 * I_DN) { const int f = r / I_DN; transpose_item(a.in[6] + (size_t)f * DFF * DM, DFF, DM, (bf16_t*)(ws + WS_DN + f * SZ_DN), DFF, 0, MAP_PLAIN, nullptr, scr, r % I_DN, F.lane); continue; } r -= 8 * I_DN;
        if (r < 4 * I_WO) { const int f = r / I_WO; transpose_item(a.in[7] + (size_t)f * DM * DM, DM, DM, (bf16_t*)(ws + WS_WOUT) + (size_t)f * DM * DM, DM, 0, MAP_PLAIN, nullptr, scr, r % I_WO, F.lane); continue; } r -= 4 * I_WO;
        if (r < 4 * I_MK) { const int f = r / I_MK; transpose_item(a.in[9] + (size_t)f * DM * 1024, DM, 1024, (bf16_t*)(ws + WS_MEMW) + (size_t)f * 1024 * DM, DM, 0, MAP_PLAIN, nullptr, scr, r % I_MK, F.lane); continue; } r -= 4 * I_MK;
        if (r < 2 * I_AI) { const int f = r / I_AI; transpose_item(a.in[10] + (size_t)f * DM * DM, DM, DM, (bf16_t*)(ws + WS_AIN) + (size_t)f * DM * DM, DM, 0, MAP_PLAIN, nullptr, scr, r % I_AI, F.lane); continue; } r -= 2 * I_AI;
        if (r < 2 * I_GL) { const int f = r / I_GL; transpose_item(a.in[19] + (size_t)f * TOKW * TOKW, TOKW, TOKW, (bf16_t*)(ws + WS_GLU) + (size_t)f * TOKW * TOKW, TOKW, 0, MAP_PLAIN, nullptr, scr, r % I_GL, F.lane); continue; } r -= 2 * I_GL;
        if (r < 2 * I_BI) { const int f = r / I_BI; transpose_item(a.in[21] + (size_t)f * DM * 1024, DM, 1024, (bf16_t*)(ws + WS_BIN) + (size_t)f * 1024 * DM, DM, 0, MAP_PLAIN, nullptr, scr, r % I_BI, F.lane); continue; } r -= 2 * I_BI;
        if (r < 2 * I_UQ) { const int f = r / I_UQ; transpose_item(a.in[23] + (size_t)f * QRANK * NH * DQKH, QRANK, NH * DQKH, (bf16_t*)(ws + WS_UQ) + (size_t)f * NH * DQKH * QRANK, QRANK, 0, MAP_UQ, a.in[22] + f * QRANK, scr, r % I_UQ, F.lane); continue; } r -= 2 * I_UQ;
        if (r < I_DK) { transpose_item(a.in[25], DM, KVRANK, (bf16_t*)(ws + WS_DKV), DM, 0, MAP_PLAIN, nullptr, scr, r, F.lane); continue; } r -= I_DK;
        if (r < I_KR) { transpose_item(a.in[29], DM, DROPE, (bf16_t*)(ws + WS_DKV), DM, KVRANK, MAP_ROPE64, nullptr, scr, r, F.lane); continue; } r -= I_KR;
        if (r < I_UK) { transpose_item(a.in[27], KVRANK, TOKW, (bf16_t*)(ws + WS_UKV), KVRANK, 0, MAP_PLAIN, a.in[26], scr, r, F.lane); continue; } r -= I_UK;
        transpose_item(a.in[28], KVRANK, TOKW, (bf16_t*)(ws + WS_UKV), KVRANK, TOKW, MAP_PLAIN, a.in[26], scr, r, F.lane);
    }
    for (int m = gw; m < M; m += NGW) rms_row_to_bf16(a.in[0] + (size_t)m * DM, a.in[3], (bf16_t*)(ws + WS_HB) + (size_t)m * DM, F.lane);
    for (int m = gw; m < 4 * 1024; m += NGW) { const int l = m >> 10, r = m & 1023; rms_row_to_bf16(a.in[1] + (size_t)r * DM, a.in[8] + l * DM, (bf16_t*)(ws + WS_MEMN) + (size_t)m * DM, F.lane); }
    const int* pos = (const int*)a.in[2];
    for (int e = (F.vcu * 512 + F.tid); e < M * 32; e += F.G * 512) { const int tok = e >> 5, i = e & 31;
        const double inv = exp2(-(double)(2 * i) * (13.287712379549449 / 64.0));
        float s, c; sincos_d((double)pos[tok] * inv, s, c); ((float*)(ws + WS_COS))[e] = c; ((float*)(ws + WS_SIN))[e] = s; }
}
__device__ __forceinline__ void thin_phase(Frame& F, const bf16_t* fsrc, const float* xsrc, float* xdst, const float* gpost, float scale, const float* gnext, bf16_t* hb, const float* gkv, bf16_t* hkv) {
    const int gw = F.vcu * NWAVES + F.wave, NGW = F.G * NWAVES, lane = F.lane;
    for (int m = gw; m < M; m += NGW) {
        const bf16_t* fr = fsrc + (size_t)m * DM; const float* xr = xsrc + (size_t)m * DM; float* xo = xdst + (size_t)m * DM;
        float f[32]; f32x4 x[8];
#pragma unroll
        for (int j = 0; j < 4; ++j) { unpack8(*(const u32x4*)(fr + j * 512 + lane * 8), f + 8 * j); x[2 * j] = *(const f32x4*)(xr + j * 512 + lane * 8); x[2 * j + 1] = *(const f32x4*)(xr + j * 512 + lane * 8 + 4); }
        float s = 0.f;
#pragma unroll
        for (int j = 0; j < 32; ++j) s += f[j] * f[j];
        const float rf = scale / sqrtf(wave_sum(s) * (1.0f / DM) + EPS);
        float s2 = 0.f;
#pragma unroll
        for (int j = 0; j < 4; ++j) { const f32x4 g0 = *(const f32x4*)(gpost + j * 512 + lane * 8), g1 = *(const f32x4*)(gpost + j * 512 + lane * 8 + 4);
#pragma unroll
            for (int e = 0; e < 4; ++e) { x[2 * j][e] += f[8 * j + e] * rf * g0[e]; x[2 * j + 1][e] += f[8 * j + 4 + e] * rf * g1[e]; }
            *(f32x4*)(xo + j * 512 + lane * 8) = x[2 * j]; *(f32x4*)(xo + j * 512 + lane * 8 + 4) = x[2 * j + 1];
            s2 += (x[2 * j][0] * x[2 * j][0] + x[2 * j][1] * x[2 * j][1]) + (x[2 * j][2] * x[2 * j][2] + x[2 * j][3] * x[2 * j][3]);
            s2 += (x[2 * j + 1][0] * x[2 * j + 1][0] + x[2 * j + 1][1] * x[2 * j + 1][1]) + (x[2 * j + 1][2] * x[2 * j + 1][2] + x[2 * j + 1][3] * x[2 * j + 1][3]); }
        const float rx = 1.0f / sqrtf(wave_sum(s2) * (1.0f / DM) + EPS);
        if (gnext) {
#pragma unroll
            for (int j = 0; j < 4; ++j) { const f32x4 g0 = *(const f32x4*)(gnext + j * 512 + lane * 8), g1 = *(const f32x4*)(gnext + j * 512 + lane * 8 + 4);
                *(u32x4*)(hb + (size_t)m * DM + j * 512 + lane * 8) = pack8(x[2 * j] * rx * g0, x[2 * j + 1] * rx * g1); } }
        if (gkv) {
#pragma unroll
            for (int j = 0; j < 4; ++j) { const f32x4 g0 = *(const f32x4*)(gkv + j * 512 + lane * 8), g1 = *(const f32x4*)(gkv + j * 512 + lane * 8 + 4);
                *(u32x4*)(hkv + (size_t)m * DM + j * 512 + lane * 8) = pack8(x[2 * j] * rx * g0, x[2 * j + 1] * rx * g1); } }
    }
}
__device__ __forceinline__ void s5_scan_phase(Frame& F, unsigned char* ws, int la) {
    const int gw = F.vcu * NWAVES + F.wave, NGW = F.G * NWAVES, p = F.lane;
    const float* SE = (const float*)(ws + WS_SEND); bf16_t* UH = (bf16_t*)(ws + WS_UH);
    for (int it = gw; it < BATCH * S5G; it += NGW) { const int b = it / S5G, g = it % S5G;
        const float* l16 = (const float*)(ws + WS_L16) + ((size_t)(la * S5G + g) * S5P + p) * 2; const float ar = l16[0], ai = l16[1];
        float hr = 0.f, hi = 0.f; const size_t row0 = (size_t)g * NCHUNK + (size_t)b * CPB;
        for (int k0 = 0; k0 < CPB; k0 += 16) { float sr[16], si[16];
#pragma unroll
            for (int k = 0; k < 16; ++k) { sr[k] = SE[(row0 + k0 + k) * 128 + p]; si[k] = SE[(row0 + k0 + k) * 128 + 64 + p]; }
#pragma unroll
            for (int k = 0; k < 16; ++k) { bf16_t* u = UH + (row0 + k0 + k) * 384 + 256; u[p] = (bf16_t)f2bf(hr); u[64 + p] = (bf16_t)f2bf(hi);
                const float nr = ar * hr - ai * hi + sr[k], ni = ar * hi + ai * hr + si[k]; hr = nr; hi = ni; } }
    }
}

__global__ void __launch_bounds__(NWAVES * 64, 2) trunk_fwd(Args args) {
    extern __shared__ __attribute__((aligned(16))) unsigned char lds_raw[];
    Frame F;
    F.lds = (LAS unsigned char*)lds_raw;
    F.tid = threadIdx.x; F.lane = F.tid & 63; F.wave = __builtin_amdgcn_readfirstlane(F.tid >> 6);
    F.G = gridDim.x; { const int bx = blockIdx.x; F.vcu = (F.G % 8 == 0) ? (bx % 8) * (F.G / 8) + bx / 8 : bx; }
    GAS unsigned char* wsg = (GAS unsigned char*)args.wsp;
#define ws ((unsigned char*)wsg)
    volatile LAS unsigned* MISC = (volatile LAS unsigned*)(F.lds + MISC_OFF);
    for (int u = F.tid; u < (LDS_BYTES - LDSCTL_OFF) / 4; u += NWAVES * 64) ((LAS unsigned*)(F.lds + LDSCTL_OFF))[u] = 0u;
    __syncthreads();
    if (!MK_PER_PHASE) (void)xcd_barrier_post((unsigned*)(ws + WS_CTL) + 1024, MISC + 8);
    const int lo = args.ph_lo, hi = args.ph_hi; int pid = 0;
#define PH_ON() (pid >= lo && pid < hi)
#define PH_FRESH() do { int t_ = threadIdx.x; asm volatile("" : "+v"(t_)); F.tid = t_; F.lane = t_ & 63; F.wave = __builtin_amdgcn_readfirstlane(t_ >> 6); wsg = (GAS unsigned char*)args.wsp; asm volatile("" : "+s"(wsg)); } while (0)
#define PH_END() do { if (!MK_PER_PHASE && pid >= lo && pid + 1 < hi) { XcdBarrier bar_; bar_.bar = (unsigned*)(ws + WS_CTL) + 1024; bar_.x = xb_xcc_id(); bar_.st = (volatile LAS unsigned*)(F.lds + MISC_OFF) + 8; xcd_barrier(bar_); } ++pid; PH_FRESH(); } while (0)
#define bx ((int)blockIdx.x)
#define X (args.out)
#define HB ((bf16_t*)(ws + WS_HB))
#define FB ((bf16_t*)(ws + WS_FB))
#define ACT ((bf16_t*)(ws + WS_ACT))
#define CAT ((bf16_t*)(ws + WS_CAT))
#define QMEM ((bf16_t*)(ws + WS_QMEM))

    if (EN(0) && PH_ON()) p0_prologue(args, F);
    PH_END();
    if (EN(1) && PH_ON()) { pg8::Gemm g{(const bf16_t*)(ws + WS_MEMN), (const bf16_t*)(ws + WS_MEMW), DM, DM, DM}; pg8::MemKvOrder S{F.G, bx}; pg8::EpiMemKv E{(bf16_t*)(ws + WS_MKV)};
        pg8::gemm_phase<pg8::EpiMemKv, pg8::MemKvOrder>(F.lds + RING_OFF, g, S, E); }
    PH_END();

    for (int hl = 0; hl < 2 * DEPTH; ++hl) {
        const int l = hl >> 1, s = hl & 1, ff = l * 2 + s;
#define gl (args.in[3] + (size_t)l * 6 * DM)
        if (EN(2) && PH_ON()) { pg8::Gemm g{HB, (const bf16_t*)(ws + WS_GU + ff * SZ_GU), DM, DM, DM}; pg8::StaticOrder S; S.init(M / 256, 2 * DFF / 256, F.G, bx); pg8::EpiSwiGLU E{ACT};
            pg8::gemm_phase<pg8::EpiSwiGLU, pg8::StaticOrder>(F.lds + RING_OFF, g, S, E); }
        PH_END();
        if (EN(3) && PH_ON()) { pg8::Gemm g{ACT, (const bf16_t*)(ws + WS_DN + ff * SZ_DN), DFF, DFF, DFF}; pg8::StaticOrder S; S.init(M / 256, DM / 256, F.G, bx); pg8::EpiBf16 E{FB, DM};
            pg8::gemm_phase<pg8::EpiBf16, pg8::StaticOrder>(F.lds + RING_OFF, g, S, E); }
        PH_END();
        if (EN(4) && PH_ON()) { const float* xsrc = (hl == 0) ? args.in[0] : X;
            const float* gnext = s == 0 ? gl + 2 * DM : (l + 1 < DEPTH ? args.in[3] + (size_t)(l + 1) * 6 * DM : nullptr);
            const float* gkv = (s == 1 && l == NA - 1) ? args.in[24] : nullptr;
            thin_phase(F, FB, xsrc, X, gl + (s == 0 ? 1 : 5) * DM, 0.5f, gnext, HB, gkv, (bf16_t*)(ws + WS_HKV)); }
        PH_END();
        if (s == 0) {
#define MK ((const bf16_t*)(ws + WS_MKV) + (size_t)l * 1024 * 1024)
            if (l < NA) {
                if (EN(5) && PH_ON()) { pg8::Gemm g{HB, (const bf16_t*)(ws + WS_AIN) + (size_t)l * DM * DM, DM, DM, DM}; pg8::StaticOrder S; S.init(M / 256, DM / 256, F.G, bx); pg8::EpiAin E{(bf16_t*)(ws + WS_UH), QMEM};
                    pg8::gemm_phase<pg8::EpiAin, pg8::StaticOrder>(F.lds + RING_OFF, g, S, E); }
                PH_END();
                if (EN(6) && PH_ON()) { pg8::Gemm g{(const bf16_t*)(ws + WS_UH), (const bf16_t*)(ws + WS_GM) + (size_t)l * S5G * 256 * 256, 256, 384, 256}; pg8::S5Order S{F.G, bx}; pg8::EpiS5State E{(float*)(ws + WS_SEND)};
                    pg8::gemm_phase<pg8::EpiS5State, pg8::S5Order>(F.lds + RING_OFF, g, S, E); }
                PH_END();
                if (EN(7) && PH_ON()) s5_scan_phase(F, ws, l);
                PH_END();
                if (EN(6) && PH_ON()) { pg8::Gemm g{(const bf16_t*)(ws + WS_UH), (const bf16_t*)(ws + WS_TF) + (size_t)l * S5G * 256 * 384, 384, 384, 384}; pg8::S5Order S{F.G, bx}; pg8::EpiS5Out E{(bf16_t*)(ws + WS_Y)};
                    pg8::gemm_phase<pg8::EpiS5Out, pg8::S5Order>(F.lds + RING_OFF, g, S, E); }
                PH_END();
                if (EN(8) && PH_ON()) { pg8::Gemm g{(const bf16_t*)(ws + WS_Y), (const bf16_t*)(ws + WS_GLU) + (size_t)l * TOKW * TOKW, TOKW, 0, TOKW}; pg8::StaticOrder S; S.init(M / 256, TOKW / 256, F.G, bx);
                    pg8::EpiGlu E{(const bf16_t*)(ws + WS_Y), args.in[20] + (size_t)l * TOKW, CAT};
                    pg8::gemm_phase<pg8::EpiGlu, pg8::StaticOrder, 1>(F.lds + RING_OFF, g, S, E); }
            } else {
                const int j = l - NA;
                if (EN(9) && PH_ON()) { pg8::Gemm g{HB, (const bf16_t*)(ws + WS_BIN) + (size_t)j * 1024 * DM, DM, DM, DM}; pg8::StaticOrder S; S.init(M / 256, 1024 / 256, F.G, bx);
                    pg8::EpiBin E{(bf16_t*)(ws + WS_CQ), (float*)(ws + WS_SSQ), QMEM};
                    pg8::gemm_phase<pg8::EpiBin, pg8::StaticOrder>(F.lds + RING_OFF, g, S, E); }
                PH_END();
                if (EN(9) && PH_ON()) { pg8::Gemm g{(const bf16_t*)(ws + WS_CQ), (const bf16_t*)(ws + WS_UQ) + (size_t)j * NH * DQKH * QRANK, QRANK, QRANK, QRANK}; pg8::StaticOrder S; S.init(M / 256, NH * DQKH / 256, F.G, bx);
                    pg8::EpiUq E{(const float*)(ws + WS_SSQ), (const float*)(ws + WS_COS), (const float*)(ws + WS_SIN), (bf16_t*)(ws + WS_Q)};
                    pg8::gemm_phase<pg8::EpiUq, pg8::StaticOrder>(F.lds + RING_OFF, g, S, E); }
                PH_END();
                if (EN(10) && PH_ON()) {
                    for (int it = F.vcu; it < 256; it += F.G) { const int tri = it >> 4, bin = it & 15;
                        for (int e = 0; e < 8; ++e) { const unsigned code = att::MLA_BINS[bin][e]; if (code == 0xFFu) break;
                            const int bh = tri * 3 + (int)(code >> 4), qb = (int)(code & 15), b = bh / NH, h = bh % NH; const size_t tok0 = (size_t)b * SEQ;
                            att::attn_unit<192, true>(F.lds + RING_OFF, (const bf16_t*)(ws + WS_Q) + (tok0 + qb * 256) * (NH * DQKH) + h * DQKH, NH * DQKH,
                                (const bf16_t*)(ws + WS_KN) + tok0 * TOKW + h * DNOPE, TOKW, (const bf16_t*)(ws + WS_KR) + tok0 * DROPE, DROPE,
                                (const bf16_t*)(ws + WS_VV) + tok0 * TOKW + h * DVH, TOKW, CAT + (tok0 + qb * 256) * DM + h * DVH, DM, qb * 256, 4 * (qb + 1), 0.07216878364870322f * 1.4426950408889634f); } }
                }
            }
            if (EN(11) && PH_ON()) {
                for (int it = F.vcu; it < BATCH * 4 * (SEQ / 256); it += F.G) { const int b = it >> 6, h = (it >> 4) & 3, qb = it & 15; const size_t tok0 = (size_t)b * SEQ + qb * 256;
                    att::attn_unit<128, false>(F.lds + RING_OFF, QMEM + tok0 * MEMW + h * 128, MEMW, MK + (size_t)b * NMEM * 1024 + h * 128, 1024, nullptr, 0,
                        MK + (size_t)b * NMEM * 1024 + MEMW + h * 128, 1024, CAT + tok0 * DM + TOKW + h * 128, DM, 0, NMEM / 64, 0.08838834764831845f * 1.4426950408889634f); }
            }
            PH_END();
            if (EN(12) && PH_ON()) { pg8::Gemm g{CAT, (const bf16_t*)(ws + WS_WOUT) + (size_t)l * DM * DM, DM, DM, DM}; pg8::StaticOrder S; S.init(M / 256, DM / 256, F.G, bx); pg8::EpiBf16 E{FB, DM};
                pg8::gemm_phase<pg8::EpiBf16, pg8::StaticOrder>(F.lds + RING_OFF, g, S, E); }
            PH_END();
            if (EN(4) && PH_ON()) thin_phase(F, FB, X, X, gl + 3 * DM, 1.0f, gl + 4 * DM, HB, nullptr, nullptr);
            PH_END();
        } else if (l == NA - 1) {
            if (EN(13) && PH_ON()) { pg8::Gemm g{(const bf16_t*)(ws + WS_HKV), (const bf16_t*)(ws + WS_DKV), DM, DM, DM}; pg8::StaticOrder S; S.init(M / 256, 3, F.G, bx);
                pg8::EpiDkv E{(bf16_t*)(ws + WS_CKV), (float*)(ws + WS_SSQ) + (size_t)M * 8, (const float*)(ws + WS_COS), (const float*)(ws + WS_SIN), (bf16_t*)(ws + WS_KR)};
                pg8::gemm_phase<pg8::EpiDkv, pg8::StaticOrder>(F.lds + RING_OFF, g, S, E); }
            PH_END();
            if (EN(13) && PH_ON()) { pg8::Gemm g{(const bf16_t*)(ws + WS_CKV), (const bf16_t*)(ws + WS_UKV), KVRANK, KVRANK, KVRANK}; pg8::StaticOrder S; S.init(M / 256, 3072 / 256, F.G, bx);
                pg8::EpiUkv E{(const float*)(ws + WS_SSQ) + (size_t)M * 8, (bf16_t*)(ws + WS_KN), (bf16_t*)(ws + WS_VV)};
                pg8::gemm_phase<pg8::EpiUkv, pg8::StaticOrder>(F.lds + RING_OFF, g, S, E); }
            PH_END();
        }
    }
#undef PH_ON
#undef PH_END
#undef ws
#undef bx
#undef X
#undef HB
#undef FB
#undef ACT
#undef CAT
#undef QMEM
#undef gl
#undef MK
}
constexpr int N_PHASES = 2 + 8 * 3 + 2 * 7 + 2 * 5 + 2;

extern "C" void kernel_launch(void* const* d_in, const int* in_sizes, int n_in, void* d_out, int out_size, void* d_ws, size_t ws_size, hipStream_t stream) {
    static int grid = 0;
    if (grid == 0) {
        if (n_in != 30 || in_sizes[0] != M * DM || out_size != M * DM || ws_size < WS_END) { fprintf(stderr, "kernel_launch: shape / workspace mismatch (n_in %d, in0 %d, out %d, ws %zu, need %zu)\n", n_in, n_in > 0 ? in_sizes[0] : -1, out_size, ws_size, (size_t)WS_END); grid = -1; return; }
        int dev = 0, cus = 0, per_cu = 0;
        if (hipGetDevice(&dev) != hipSuccess || hipDeviceGetAttribute(&cus, hipDeviceAttributeMultiprocessorCount, dev) != hipSuccess) { grid = -1; return; }
        if (hipFuncSetAttribute((const void*)trunk_fwd, hipFuncAttributeMaxDynamicSharedMemorySize, LDS_BYTES) != hipSuccess) { fprintf(stderr, "kernel_launch: hipFuncSetAttribute failed\n"); grid = -1; return; }
        if (hipOccupancyMaxActiveBlocksPerMultiprocessor(&per_cu, (const void*)trunk_fwd, NWAVES * 64, LDS_BYTES) != hipSuccess || per_cu < 1) { fprintf(stderr, "kernel_launch: occupancy query reports %d\n", per_cu); }
        (void)hipGetLastError();
        grid = cus;
    }
    if (grid < 0) return;
    if (hipMemsetAsync((char*)d_ws + WS_CTL, 0, CTL_ZERO_BYTES, stream) != hipSuccess) return;
    Args a{};
    for (int i = 0; i < 30; ++i) a.in[i] = (const float*)d_in[i];
    a.out = (float*)d_out; a.wsp = (unsigned char*)d_ws;
#if MK_PER_PHASE
    for (int p = 0; p < N_PHASES; ++p) { a.ph_lo = p; a.ph_hi = p + 1; hipLaunchKernelGGL(trunk_fwd, dim3(grid), dim3(NWAVES * 64), LDS_BYTES, stream, a); }
#else
    a.ph_lo = 0; a.ph_hi = N_PHASES;
    hipLaunchKernelGGL(trunk_fwd, dim3(grid), dim3(NWAVES * 64), LDS_BYTES, stream, a);
#endif
    const hipError_t le = hipPeekAtLastError();
    if (le != hipSuccess) fprintf(stderr, "kernel_launch: launch failed: %s\n", hipGetErrorName(le));
}
```

```cpp
#include <hip/hip_runtime.h>
#include <cstdio>
#include <cstdint>

#ifndef MK_PER_PHASE
#define MK_PER_PHASE 0
#endif

#ifndef EN_MASK
#define EN_MASK 0xFFFF
#endif
#define EN(b) ((EN_MASK >> (b)) & 1)
#ifndef REP_MASK
#define REP_MASK 0
#endif
#define REPG(b) ((REP_MASK >> (b)) & 1)
#ifndef NPASS
#define NPASS 1
#endif
constexpr int DM = 2048, BATCH = 4, SEQ = 4096, M = BATCH * SEQ, DEPTH = 4, NA = 2;
constexpr int NMEM = 256, MEMW = 512, TOKW = 1536, DFF = 5632;
constexpr int S5G = 96, S5P = 64, S5C = 16, S5T = 16, NCHUNK = M / S5T, CPB = SEQ / S5T;
constexpr int QRANK = 512, KVRANK = 512, NH = 12, DNOPE = 128, DROPE = 64, DQKH = 192, DVH = 128;
constexpr float EPS = 1e-6f;
constexpr int YGS = NCHUNK * 256;

#define GAS __attribute__((address_space(1)))
#define LAS __attribute__((address_space(3)))
typedef unsigned short bf16_t;
typedef short bf16x8 __attribute__((ext_vector_type(8)));
typedef short s16x4 __attribute__((ext_vector_type(4)));
typedef float f32x4 __attribute__((ext_vector_type(4)));
typedef float f32x2 __attribute__((ext_vector_type(2)));
typedef float f32x16 __attribute__((ext_vector_type(16)));
typedef unsigned u32x4 __attribute__((ext_vector_type(4)));
typedef unsigned u32x2 __attribute__((ext_vector_type(2)));

__device__ __forceinline__ unsigned cvt_pk_bf16(float lo, float hi) { unsigned r; asm volatile("v_cvt_pk_bf16_f32 %0, %1, %2" : "=v"(r) : "v"(lo), "v"(hi)); return r; }
__device__ __forceinline__ u32x4 pack8(f32x4 a, f32x4 b) { u32x4 w; w.x = cvt_pk_bf16(a[0], a[1]); w.y = cvt_pk_bf16(a[2], a[3]); w.z = cvt_pk_bf16(b[0], b[1]); w.w = cvt_pk_bf16(b[2], b[3]); return w; }
__device__ __forceinline__ float bf2f(unsigned short b) { return __uint_as_float(((unsigned)b) << 16); }
__device__ __forceinline__ void unpack8(u32x4 w, float* o) { o[0] = __uint_as_float(w.x << 16); o[1] = __uint_as_float(w.x & 0xffff0000u); o[2] = __uint_as_float(w.y << 16); o[3] = __uint_as_float(w.y & 0xffff0000u);
    o[4] = __uint_as_float(w.z << 16); o[5] = __uint_as_float(w.z & 0xffff0000u); o[6] = __uint_as_float(w.w << 16); o[7] = __uint_as_float(w.w & 0xffff0000u); }
__device__ __forceinline__ float fast_sigmoid(float v) { return __builtin_amdgcn_rcpf(1.0f + __builtin_amdgcn_exp2f(-1.4426950408889634f * v)); }
__device__ __forceinline__ float gelu_tanh(float v) { const float u = 0.7978845608028654f * (v + 0.044715f * v * v * v); const float t = 1.0f - 2.0f * __builtin_amdgcn_rcpf(__builtin_amdgcn_exp2f(2.885390081777927f * u) + 1.0f); return 0.5f * v * (1.0f + t); }

namespace pg8 {
constexpr int BM = 256, BK = 64, HALF = 128, HTB = HALF * BK * 2, STAGE_BYTES = 8 * HTB, NXCD = 8, WGM = 8;
__host__ __device__ __forceinline__ int lds_byte(int r, int c) { const int st = (r >> 4) * 2 + (c >> 5), rr = r & 15, cc = c & 31, ob = rr * 64 + cc * 2; return st * 1024 + (ob ^ (((ob >> 9) & 1) << 5)); }
__host__ __device__ __forceinline__ void stage_rc(int b, int& R, int& C) { const int st = b / 1024, sb = b % 1024, swz = sb ^ (((sb >> 9) & 1) << 5); R = (st >> 1) * 16 + swz / 64; C = (st & 1) * 32 + (swz % 64) / 2; }
__host__ __device__ __forceinline__ int perm32(int rho) { const int n = rho >> 4, i = rho & 15; return 8 * (i >> 2) + 4 * n + (i & 3); }

struct Unit { int pm, pn; };
struct Gemm { const bf16_t* A; const bf16_t* Bt; int K; int lda; int ldb; };

struct StaticOrder {
    int nM, nN, nwg, G, c;
    __device__ __forceinline__ void init(int nM_, int nN_, int G_, int c_) { nM = nM_; nN = nN_; nwg = nM * nN; G = G_; c = c_; }
    __device__ __forceinline__ bool next(int i, Unit& u) const {
        const long L = (long)i * G + c; if (L >= nwg) return false;
        int wgid = (int)L; { const int q = nwg / NXCD, r = nwg % NXCD, xcd = wgid % NXCD, off = wgid / NXCD; wgid = (xcd < r ? xcd * (q + 1) : r * (q + 1) + (xcd - r) * q) + off; }
        const int nig = WGM * nN, gid = wgid / nig, fm = gid * WGM, gsz = (nM - fm) < WGM ? (nM - fm) : WGM;
        u.pm = fm + ((wgid % nig) % gsz); u.pn = (wgid % nig) / gsz; return true;
    }
};
struct S5Order {
    int G, c;
    __device__ __forceinline__ bool next(int i, Unit& u) const { const int L = i * G + c; if (L >= S5G * 4) return false; u.pm = L; u.pn = L >> 2; return true; }
};
struct MemKvOrder {
    int G, c;
    __device__ __forceinline__ bool next(int i, Unit& u) const { const int L = i * G + c; if (L >= 64) return false; const int l = L >> 4, r = L & 15; u.pm = l * 4 + (r >> 2); u.pn = l * 4 + (r & 3); return true; }
};

struct EpiBf16 {
    static constexpr bool PERM = true;
    bf16_t* O; int ldc;
    __device__ __forceinline__ void operator()(const f32x4 (&acc)[2][2][4][2], const Unit& u, int wr, int wc, int fr, int fq) const {
        const int row0 = u.pm * BM + wr * 64 + fr, col0 = u.pn * BM + wc * 32 + 8 * fq;
#pragma unroll
        for (int ai = 0; ai < 2; ++ai)
#pragma unroll
            for (int m = 0; m < 4; ++m) { bf16_t* rowp = O + (size_t)(row0 + ai * HALF + m * 16) * ldc + col0;
#pragma unroll
                for (int bj = 0; bj < 2; ++bj) *(u32x4*)(rowp + bj * HALF) = pack8(acc[ai][bj][m][0], acc[ai][bj][m][1]); }
    }
};
struct EpiMemKv {
    static constexpr bool PERM = true;
    bf16_t* O;
    __device__ __forceinline__ void operator()(const f32x4 (&acc)[2][2][4][2], const Unit& u, int wr, int wc, int fr, int fq) const {
        const int row0 = u.pm * BM + wr * 64 + fr, col0 = (u.pn & 3) * BM + wc * 32 + 8 * fq;
#pragma unroll
        for (int ai = 0; ai < 2; ++ai)
#pragma unroll
            for (int m = 0; m < 4; ++m) { bf16_t* rowp = O + (size_t)(row0 + ai * HALF + m * 16) * 1024 + col0;
#pragma unroll
                for (int bj = 0; bj < 2; ++bj) *(u32x4*)(rowp + bj * HALF) = pack8(acc[ai][bj][m][0], acc[ai][bj][m][1]); }
    }
};
struct EpiSwiGLU {
    static constexpr bool PERM = true;
    bf16_t* O;
    __device__ __forceinline__ void operator()(const f32x4 (&acc)[2][2][4][2], const Unit& u, int wr, int wc, int fr, int fq) const {
        const int row0 = u.pm * BM + wr * 64 + fr, col0 = u.pn * HALF + wc * 32 + 8 * fq;
#pragma unroll
        for (int ai = 0; ai < 2; ++ai)
#pragma unroll
            for (int m = 0; m < 4; ++m) { bf16_t* rowp = O + (size_t)(row0 + ai * HALF + m * 16) * DFF + col0;
                f32x4 v0, v1;
#pragma unroll
                for (int j = 0; j < 4; ++j) { const float g0 = acc[ai][0][m][0][j], g1 = acc[ai][0][m][1][j]; v0[j] = g0 * fast_sigmoid(g0) * acc[ai][1][m][0][j]; v1[j] = g1 * fast_sigmoid(g1) * acc[ai][1][m][1][j]; }
                *(u32x4*)rowp = pack8(v0, v1); }
    }
};
struct EpiAin {
    static constexpr bool PERM = true;
    bf16_t* UH; bf16_t* QM;
    __device__ __forceinline__ void operator()(const f32x4 (&acc)[2][2][4][2], const Unit& u, int wr, int wc, int fr, int fq) const {
        const int row0 = u.pm * BM + wr * 64 + fr;
#pragma unroll
        for (int ai = 0; ai < 2; ++ai)
#pragma unroll
            for (int m = 0; m < 4; ++m) { const int row = row0 + ai * HALF + m * 16;
#pragma unroll
                for (int bj = 0; bj < 2; ++bj) { const int c0 = u.pn * BM + bj * HALF + wc * 32 + 8 * fq; const u32x4 w = pack8(acc[ai][bj][m][0], acc[ai][bj][m][1]);
                    if (u.pn < 6) *(u32x4*)(UH + ((size_t)(c0 >> 4) * NCHUNK + (row >> 4)) * 384 + (row & 15) * 16 + (c0 & 15)) = w;
                    else *(u32x4*)(QM + (size_t)row * MEMW + (c0 - TOKW)) = w; } }
    }
};
struct EpiS5State {
    static constexpr bool PERM = false;
    float* SE;
    __device__ __forceinline__ void operator()(const f32x4 (&acc)[2][2][4][2], const Unit& u, int wr, int wc, int fr, int fq) const {
        const int row0 = u.pm * BM + wr * 64 + fr, col0 = wc * 32 + 4 * fq;
#pragma unroll
        for (int ai = 0; ai < 2; ++ai)
#pragma unroll
            for (int m = 0; m < 4; ++m) { float* rowp = SE + (size_t)(row0 + ai * HALF + m * 16) * 128 + col0;
#pragma unroll
                for (int n = 0; n < 2; ++n) *(f32x4*)(rowp + n * 16) = acc[ai][0][m][n]; }
    }
};
struct EpiS5Out {
    static constexpr bool PERM = true;
    bf16_t* Y;
    __device__ __forceinline__ void operator()(const f32x4 (&acc)[2][2][4][2], const Unit& u, int wr, int wc, int fr, int fq) const {
        const int row0 = u.pm * BM + wr * 64 + fr, col0 = wc * 32 + 8 * fq;
#pragma unroll
        for (int ai = 0; ai < 2; ++ai)
#pragma unroll
            for (int m = 0; m < 4; ++m) { bf16_t* rowp = Y + (size_t)(row0 + ai * HALF + m * 16) * 256 + col0;
#pragma unroll
                for (int bj = 0; bj < 2; ++bj) { f32x4 v0, v1;
#pragma unroll
                    for (int j = 0; j < 4; ++j) { v0[j] = gelu_tanh(acc[ai][bj][m][0][j]); v1[j] = gelu_tanh(acc[ai][bj][m][1][j]); }
                    *(u32x4*)(rowp + bj * HALF) = pack8(v0, v1); } }
    }
};
struct EpiGlu {
    static constexpr bool PERM = true;
    const bf16_t* Y; const float* bias; bf16_t* CAT;
    __device__ __forceinline__ void operator()(const f32x4 (&acc)[2][2][4][2], const Unit& u, int wr, int wc, int fr, int fq) const {
        const int row0 = u.pm * BM + wr * 64 + fr;
#pragma unroll
        for (int bj = 0; bj < 2; ++bj) { const int c0 = u.pn * BM + bj * HALF + wc * 32 + 8 * fq;
            const f32x4 b0 = *(const f32x4*)(bias + c0), b1 = *(const f32x4*)(bias + c0 + 4);
#pragma unroll
            for (int ai = 0; ai < 2; ++ai)
#pragma unroll
                for (int m = 0; m < 4; ++m) { const int row = row0 + ai * HALF + m * 16;
                    const u32x4 yw = *(const u32x4*)(Y + (size_t)(c0 >> 4) * YGS + (size_t)(row >> 4) * 256 + (row & 15) * 16 + (c0 & 15));
                    float y[8]; unpack8(yw, y); f32x4 v0, v1;
#pragma unroll
                    for (int j = 0; j < 4; ++j) { v0[j] = y[j] * fast_sigmoid(acc[ai][bj][m][0][j] + b0[j]); v1[j] = y[4 + j] * fast_sigmoid(acc[ai][bj][m][1][j] + b1[j]); }
                    *(u32x4*)(CAT + (size_t)row * DM + c0) = pack8(v0, v1); asm volatile("" ::: "memory"); } }
    }
};
__device__ __forceinline__ void ssq_partial(const f32x4 (&acc)[2][2][4][2], int ai, int m, float* SSQ, int row, int pn, int wc, int fq) {
    float s = 0.f;
#pragma unroll
    for (int bj = 0; bj < 2; ++bj)
#pragma unroll
        for (int n = 0; n < 2; ++n) { const f32x4 x = acc[ai][bj][m][n]; s += (x[0] * x[0] + x[1] * x[1]) + (x[2] * x[2] + x[3] * x[3]); }
    s += __shfl_xor(s, 16); s += __shfl_xor(s, 32);
    if (fq == 0) SSQ[(size_t)row * 8 + pn * 4 + wc] = s;
}
struct EpiBin {
    static constexpr bool PERM = true;
    bf16_t* CQ; float* SSQ; bf16_t* QM;
    __device__ __forceinline__ void operator()(const f32x4 (&acc)[2][2][4][2], const Unit& u, int wr, int wc, int fr, int fq) const {
        const int row0 = u.pm * BM + wr * 64 + fr;
#pragma unroll
        for (int ai = 0; ai < 2; ++ai)
#pragma unroll
            for (int m = 0; m < 4; ++m) { const int row = row0 + ai * HALF + m * 16;
                if (u.pn < 2) ssq_partial(acc, ai, m, SSQ, row, u.pn, wc, fq);
#pragma unroll
                for (int bj = 0; bj < 2; ++bj) { const int c0 = u.pn * BM + bj * HALF + wc * 32 + 8 * fq; const u32x4 w = pack8(acc[ai][bj][m][0], acc[ai][bj][m][1]);
                    if (u.pn < 2) *(u32x4*)(CQ + (size_t)row * QRANK + c0) = w; else *(u32x4*)(QM + (size_t)row * MEMW + (c0 - QRANK)) = w; } }
    }
};
__device__ __forceinline__ float rstd_from_ssq(const float* SSQ, int row) { const f32x4 a = *(const f32x4*)(SSQ + (size_t)row * 8), b = *(const f32x4*)(SSQ + (size_t)row * 8 + 4);
    return 1.0f / sqrtf(((a[0] + a[1]) + (a[2] + a[3]) + (b[0] + b[1]) + (b[2] + b[3])) * (1.0f / 512.0f) + EPS); }
__device__ __forceinline__ void rope_store(f32x4 t1, f32x4 t2, const float* cs, const float* sn, int row, int i0, bf16_t* dst  ) {
    const f32x4 c = *(const f32x4*)(cs + (size_t)row * 32 + i0), s = *(const f32x4*)(sn + (size_t)row * 32 + i0);
    const f32x4 o1 = t1 * c - t2 * s, o2 = t1 * s + t2 * c;
    u32x2 w1, w2; w1.x = cvt_pk_bf16(o1[0], o1[1]); w1.y = cvt_pk_bf16(o1[2], o1[3]); w2.x = cvt_pk_bf16(o2[0], o2[1]); w2.y = cvt_pk_bf16(o2[2], o2[3]);
    *(u32x2*)(dst + i0) = w1; *(u32x2*)(dst + 32 + i0) = w2;
}
struct EpiUq {
    static constexpr bool PERM = true;
    const float* SSQ; const float* cs; const float* sn; bf16_t* Q;
    __device__ __forceinline__ void operator()(const f32x4 (&acc)[2][2][4][2], const Unit& u, int wr, int wc, int fr, int fq) const {
        const int row0 = u.pm * BM + wr * 64 + fr;
#pragma unroll
        for (int ai = 0; ai < 2; ++ai)
#pragma unroll
            for (int m = 0; m < 4; ++m) { const int row = row0 + ai * HALF + m * 16; const float rs = rstd_from_ssq(SSQ, row);
#pragma unroll
                for (int bj = 0; bj < 2; ++bj) { const int c0 = u.pn * BM + bj * HALF + wc * 32 + 8 * fq; const int h = c0 / DQKH, j = c0 - h * DQKH;
                    const f32x4 a0 = acc[ai][bj][m][0] * rs, a1 = acc[ai][bj][m][1] * rs;
                    if (j < DNOPE) *(u32x4*)(Q + (size_t)row * (NH * DQKH) + c0) = pack8(a0, a1);
                    else rope_store(a0, a1, cs, sn, row, ((j - DNOPE) >> 3) * 4, Q + (size_t)row * (NH * DQKH) + h * DQKH + DNOPE); }
                asm volatile("" ::: "memory"); }
    }
};
struct EpiDkv {
    static constexpr bool PERM = true;
    bf16_t* CKV; float* SSQ; const float* cs; const float* sn; bf16_t* KR;
    __device__ __forceinline__ void operator()(const f32x4 (&acc)[2][2][4][2], const Unit& u, int wr, int wc, int fr, int fq) const {
        const int row0 = u.pm * BM + wr * 64 + fr;
#pragma unroll
        for (int ai = 0; ai < 2; ++ai)
#pragma unroll
            for (int m = 0; m < 4; ++m) { const int row = row0 + ai * HALF + m * 16;
                if (u.pn < 2) { ssq_partial(acc, ai, m, SSQ, row, u.pn, wc, fq);
#pragma unroll
                    for (int bj = 0; bj < 2; ++bj) *(u32x4*)(CKV + (size_t)row * KVRANK + u.pn * BM + bj * HALF + wc * 32 + 8 * fq) = pack8(acc[ai][bj][m][0], acc[ai][bj][m][1]); }
                else if (wc < 2) rope_store(acc[ai][0][m][0], acc[ai][0][m][1], cs, sn, row, (wc * 4 + fq) * 4, KR + (size_t)row * DROPE);
                asm volatile("" ::: "memory"); }
    }
};
struct EpiUkv {
    static constexpr bool PERM = true;
    const float* SSQ; bf16_t* KN; bf16_t* VV;
    __device__ __forceinline__ void operator()(const f32x4 (&acc)[2][2][4][2], const Unit& u, int wr, int wc, int fr, int fq) const {
        const int row0 = u.pm * BM + wr * 64 + fr; bf16_t* base = u.pn < 6 ? KN : VV; const int colt = (u.pn < 6 ? u.pn : u.pn - 6) * BM + wc * 32 + 8 * fq;
#pragma unroll
        for (int ai = 0; ai < 2; ++ai)
#pragma unroll
            for (int m = 0; m < 4; ++m) { const int row = row0 + ai * HALF + m * 16; const float rs = rstd_from_ssq(SSQ, row);
#pragma unroll
                for (int bj = 0; bj < 2; ++bj) *(u32x4*)(base + (size_t)row * TOKW + colt + bj * HALF) = pack8(acc[ai][bj][m][0] * rs, acc[ai][bj][m][1] * rs);
                asm volatile("" ::: "memory"); }
    }
};

template <class Epi, class Sched, int AMODE = 0, bool ALIGN_EPI = true>
__device__ __forceinline__ void gemm_phase(LAS unsigned char* lds, const Gemm g, const Sched& S, const Epi& E) {
    int tid = threadIdx.x; asm volatile("" : "+v"(tid));
    const int wid = __builtin_amdgcn_readfirstlane(tid >> 6), lane = tid & 63, wr = wid >> 2, wc = wid & 3, fr = lane & 15, fq = lane >> 4;
    const int nt = g.K / BK;
    unsigned voffA[2], voffB[2];
#pragma unroll
    for (int i = 0; i < 2; ++i) { int R, C; stage_rc(tid * 16 + i * 8192, R, C); const int Rb = Epi::PERM ? ((R & ~31) + perm32(R & 31)) : R;
        if (AMODE == 0) voffA[i] = (unsigned)(R * g.lda + C) * 2u; else voffA[i] = (unsigned)((C >> 4) * YGS + (R >> 4) * 256 + (R & 15) * 16 + (C & 15)) * 2u;
        voffB[i] = (unsigned)(Rb * g.ldb + C) * 2u; }
    const size_t kstepA = AMODE == 0 ? (size_t)(BK * 2) : (size_t)4 * YGS * 2, kstepB = (size_t)(BK * 2);
    const size_t hstepA = AMODE == 0 ? (size_t)HALF * g.lda * 2 : (size_t)8 * 256 * 2, hstepB = (size_t)HALF * g.ldb * 2;
    const size_t tstepA = 2 * hstepA, tstepB = 2 * hstepB;
    const unsigned ldsw = (unsigned)wid * 1024u;
    const int aoff = lds_byte(wr * 64 + fr, fq * 8), boff = lds_byte(wc * 32 + fr, fq * 8);
#define PG8_SA(b, h) (((b) * 2 + (h)) * HTB)
#define PG8_SB(b, h) ((4 + (b) * 2 + (h)) * HTB)
#define PG8_STAGE(bufoff, gbase, voff) do { _Pragma("unroll") for (int _i = 0; _i < 2; ++_i) \
        __builtin_amdgcn_global_load_lds((const unsigned*)((const char*)(gbase) + (voff)[_i]), (LAS unsigned*)(lds + (bufoff) + ldsw + _i * 8192), 16, 0, 0); } while (0)
#define PG8_LDA(dst, b, h) do { _Pragma("unroll") for (int m = 0; m < 4; ++m) _Pragma("unroll") for (int k = 0; k < 2; ++k) dst[m][k] = *(const LAS bf16x8*)(lds + PG8_SA(b, h) + aoff + m * 2048 + k * 1024); } while (0)
#define PG8_LDB(dst, b, h) do { _Pragma("unroll") for (int n = 0; n < 2; ++n) _Pragma("unroll") for (int k = 0; k < 2; ++k) dst[n][k] = *(const LAS bf16x8*)(lds + PG8_SB(b, h) + boff + n * 2048 + k * 1024); } while (0)
#define PG8_MMA(ai, bj, At, Bt) do { __builtin_amdgcn_s_setprio(1); _Pragma("unroll") for (int m = 0; m < 4; ++m) _Pragma("unroll") for (int n = 0; n < 2; ++n) _Pragma("unroll") for (int k = 0; k < 2; ++k) \
        acc[ai][bj][m][n] = __builtin_amdgcn_mfma_f32_16x16x32_bf16(Bt[n][k], At[m][k], acc[ai][bj][m][n], 0, 0, 0); __builtin_amdgcn_s_setprio(0); } while (0)
#define PG8_WAIT_V(n) asm volatile("s_waitcnt vmcnt(" #n ")" ::: "memory")
#define PG8_WAIT_L(n) asm volatile("s_waitcnt lgkmcnt(" #n ")" ::: "memory")
#define PG8_BAR __builtin_amdgcn_s_barrier()
#define PG8_SCHED __builtin_amdgcn_sched_barrier(0)
    Unit cur, nxt; int ui = 0;
    if (!S.next(0, cur)) return;
    f32x4 acc[2][2][4][2];
#pragma unroll
    for (int a = 0; a < 2; ++a)
#pragma unroll
        for (int b = 0; b < 2; ++b)
#pragma unroll
            for (int m = 0; m < 4; ++m)
#pragma unroll
                for (int n = 0; n < 2; ++n) acc[a][b][m][n] = (f32x4){0.f, 0.f, 0.f, 0.f};
    bf16x8 At[4][2], B0[2][2], B1[2][2];
    const char* cA = (const char*)g.A + (size_t)cur.pm * tstepA; const char* cB = (const char*)g.Bt + (size_t)cur.pn * tstepB;
    PG8_STAGE(PG8_SB(0, 0), cB, voffB); PG8_STAGE(PG8_SB(0, 1), cB + hstepB, voffB); PG8_STAGE(PG8_SA(0, 0), cA, voffA); PG8_STAGE(PG8_SA(0, 1), cA + hstepA, voffA);
    if (wr == 1) PG8_BAR;
    PG8_WAIT_V(2); PG8_BAR;
    PG8_STAGE(PG8_SB(1, 0), cB + kstepB, voffB); PG8_STAGE(PG8_SA(1, 0), cA + kstepA, voffA); PG8_STAGE(PG8_SB(1, 1), cB + hstepB + kstepB, voffB);
    PG8_WAIT_V(6); PG8_BAR;
    for (;;) {
        const bool has_next = S.next(ui + 1, nxt);
        const char* nA = has_next ? (const char*)g.A + (size_t)nxt.pm * tstepA : cA; const char* nB = has_next ? (const char*)g.Bt + (size_t)nxt.pn * tstepB : cB;
#pragma unroll 1
        for (int t = 0; t < nt; t += 2) {
            const bool last = (t == nt - 2);
            const char* a1 = cA + (size_t)(t + 1) * kstepA;
            const char* a2 = last ? nA : cA + (size_t)(t + 2) * kstepA; const char* b2 = last ? nB : cB + (size_t)(t + 2) * kstepB;
            const char* a3 = a2 + kstepA; const char* b3 = b2 + kstepB;
            PG8_LDB(B0, 0, 0); PG8_LDB(B1, 0, 1); PG8_SCHED; PG8_LDA(At, 0, 0); PG8_STAGE(PG8_SA(1, 1), a1 + hstepA, voffA);
            PG8_WAIT_V(8); PG8_WAIT_L(0); PG8_BAR; PG8_MMA(0, 0, At, B0); PG8_MMA(0, 1, At, B1); PG8_BAR; PG8_SCHED;
            PG8_LDA(At, 0, 1); PG8_STAGE(PG8_SB(0, 0), b2, voffB); PG8_STAGE(PG8_SB(0, 1), b2 + hstepB, voffB); PG8_STAGE(PG8_SA(0, 0), a2, voffA);
            PG8_WAIT_V(8); PG8_WAIT_L(0); PG8_BAR; PG8_MMA(1, 0, At, B0); PG8_MMA(1, 1, At, B1); PG8_BAR; PG8_SCHED;
            PG8_LDB(B0, 1, 0); PG8_LDB(B1, 1, 1); PG8_SCHED; PG8_LDA(At, 1, 0); PG8_STAGE(PG8_SA(0, 1), a2 + hstepA, voffA);
            PG8_WAIT_V(8); PG8_WAIT_L(0); PG8_BAR; PG8_MMA(0, 0, At, B0); PG8_MMA(0, 1, At, B1); PG8_BAR; PG8_SCHED;
            PG8_LDA(At, 1, 1); PG8_STAGE(PG8_SB(1, 0), b3, voffB); PG8_STAGE(PG8_SB(1, 1), b3 + hstepB, voffB); PG8_STAGE(PG8_SA(1, 0), a3, voffA);
            PG8_WAIT_V(8); PG8_WAIT_L(0); PG8_BAR; PG8_MMA(1, 0, At, B0); PG8_MMA(1, 1, At, B1); PG8_BAR; PG8_SCHED;
        }
        if constexpr (ALIGN_EPI) { if (wr == 0) PG8_BAR; }
        E(acc, cur, wr, wc, fr, fq);
        if (!has_next) break;
#pragma unroll
        for (int a = 0; a < 2; ++a)
#pragma unroll
            for (int b = 0; b < 2; ++b)
#pragma unroll
                for (int m = 0; m < 4; ++m)
#pragma unroll
                    for (int n = 0; n < 2; ++n) acc[a][b][m][n] = (f32x4){0.f, 0.f, 0.f, 0.f};
        cur = nxt; cA = nA; cB = nB; ++ui;
        if constexpr (ALIGN_EPI) { if (wr == 1) PG8_BAR; }
    }
    PG8_WAIT_V(0);
    if constexpr (!ALIGN_EPI) { if (wr == 0) PG8_BAR; }
    PG8_BAR;
#undef PG8_SA
#undef PG8_SB
#undef PG8_STAGE
#undef PG8_LDA
#undef PG8_LDB
#undef PG8_MMA
#undef PG8_WAIT_V
#undef PG8_WAIT_L
#undef PG8_BAR
#undef PG8_SCHED
}
}

namespace att {
#define SBAR() __builtin_amdgcn_sched_barrier(0)
__device__ __forceinline__ int v_st(int k, int c) { const int kk = (k & ~0xC) | ((k & 4) << 1) | ((k & 8) >> 1); return ((kk >> 3) * 4 + (c >> 5)) * 512 + ((kk & 7) * 32 + (c & 31)) * 2; }
__device__ __forceinline__ int v_rd_base(int lane) { return ((lane & 3) << 3) | (((lane >> 2) & 3) << 6) | (((lane >> 4) & 1) << 5) | (((lane >> 5) & 1) << 8); }
constexpr int v_rd_off(int d0, int ks, int half) { return d0 * 512 + ks * 4096 + half * 2048; }
__device__ __forceinline__ int crow(int r, int hi) { return (r & 3) + 8 * (r >> 2) + 4 * hi; }
constexpr int SHM_V = 64 * 128 * 2;
__device__ __forceinline__ void mask_tile(f32x16& p0, f32x16& p1, int dq) {
    const float NEG = -__builtin_inff();
#pragma unroll
    for (int r = 0; r < 16; ++r) { const int c = (r & 3) + 8 * (r >> 2); if (dq - c < 0) p0[r] = NEG; if (dq - c - 32 < 0) p1[r] = NEG; }
}
__device__ __forceinline__ void partialSM(f32x16& p0, f32x16& p1, float& m_reg, float& mn, float& alpha, const float C2  ) {
    float pmax = p0[0];
#pragma unroll
    for (int r = 1; r < 16; ++r) pmax = fmaxf(pmax, p0[r]);
#pragma unroll
    for (int r = 0; r < 16; ++r) pmax = fmaxf(pmax, p1[r]);
    { auto rr = __builtin_amdgcn_permlane32_swap(__float_as_uint(pmax), __float_as_uint(pmax), false, false); pmax = fmaxf(__uint_as_float(rr[0]), __uint_as_float(rr[1])); }
    if (__builtin_expect(__all((pmax - m_reg) * C2 <= 11.5f), 1)) { mn = m_reg; alpha = 1.f; }
    else { mn = fmaxf(m_reg, pmax); alpha = __builtin_amdgcn_exp2f((m_reg - mn) * C2); m_reg = mn; }
    const float mnL = -mn * C2;
#pragma unroll
    for (int r = 0; r < 16; ++r) p0[r] = fmaf(p0[r], C2, mnL);
#pragma unroll
    for (int r = 0; r < 16; ++r) p1[r] = fmaf(p1[r], C2, mnL);
#pragma unroll
    for (int r = 0; r < 16; ++r) p0[r] = __builtin_amdgcn_exp2f(p0[r]);
}
__device__ __forceinline__ void finishSM(f32x16& p0, f32x16& p1, float alpha, float& l_reg, bf16x8& pa0, bf16x8& pa1, bf16x8& pa2, bf16x8& pa3) {
#pragma unroll
    for (int r = 0; r < 16; ++r) p1[r] = __builtin_amdgcn_exp2f(p1[r]);
    float ps = 0;
#pragma unroll
    for (int r = 0; r < 16; ++r) ps += p0[r];
#pragma unroll
    for (int r = 0; r < 16; ++r) ps += p1[r];
    { auto rr = __builtin_amdgcn_permlane32_swap(__float_as_uint(ps), __float_as_uint(ps), false, false); ps = __uint_as_float(rr[0]) + __uint_as_float(rr[1]); }
    l_reg = l_reg * alpha + ps;
#define PK4(P, B_, OUT) do { unsigned a0 = cvt_pk_bf16(P[B_+0], P[B_+1]), a1 = cvt_pk_bf16(P[B_+2], P[B_+3]); \
        unsigned b0 = cvt_pk_bf16(P[B_+4], P[B_+5]), b1 = cvt_pk_bf16(P[B_+6], P[B_+7]); \
        auto r0 = __builtin_amdgcn_permlane32_swap(a0, b0, false, false); auto r1 = __builtin_amdgcn_permlane32_swap(a1, b1, false, false); \
        u32x4 w = {r0[0], r1[0], r0[1], r1[1]}; OUT = *reinterpret_cast<bf16x8*>(&w); } while (0)
    PK4(p0, 0, pa0); PK4(p0, 8, pa1); PK4(p1, 0, pa2); PK4(p1, 8, pa3);
#undef PK4
}
template <int KB, int DQK>
__device__ __forceinline__ void qkt(f32x16& p0, f32x16& p1, const LAS unsigned char* K_lds, int r32, int hi, const bf16x8* qr) {
    constexpr int KROW = DQK * 2, SHM_K = 64 * KROW;
    p0 = f32x16{}; p1 = f32x16{};
    const int sw = (r32 & 7) << 4;
#pragma unroll
    for (int d0 = 0; d0 < DQK / 16; ++d0) { const LAS unsigned char* a = K_lds + KB * SHM_K + r32 * KROW + ((d0 * 32 + hi * 16) ^ sw);
        const bf16x8 b0 = *(const LAS bf16x8*)a, b1 = *(const LAS bf16x8*)(a + 32 * KROW);
        p0 = __builtin_amdgcn_mfma_f32_32x32x16_bf16(b0, qr[d0], p0, 0, 0, 0);
        p1 = __builtin_amdgcn_mfma_f32_32x32x16_bf16(b1, qr[d0], p1, 0, 0, 0); }
}
template <int VB>
__device__ __forceinline__ void pv_tile(f32x16* o, int vb0, bf16x8 pa0, bf16x8 pa1, bf16x8 pa2, bf16x8 pa3) {
#define TRRD(dst, off) asm volatile("ds_read_b64_tr_b16 %0, %1 offset:%2" : "=&v"(dst) : "v"(vb0), "i"(off) : "memory")
#define PV_D0(d0) do { s16x4 l0, l1, l2, l3, h0, h1, h2, h3; constexpr int b_ = VB * SHM_V + v_rd_off(d0, 0, 0); \
        TRRD(l0, b_); TRRD(h0, b_ + 2048); TRRD(l1, b_ + 4096); TRRD(h1, b_ + 6144); TRRD(l2, b_ + 8192); TRRD(h2, b_ + 10240); TRRD(l3, b_ + 12288); TRRD(h3, b_ + 14336); \
        asm volatile("s_waitcnt lgkmcnt(0)" ::: "memory"); SBAR(); \
        o[d0] = __builtin_amdgcn_mfma_f32_32x32x16_bf16(pa0, (bf16x8){l0[0], l0[1], l0[2], l0[3], h0[0], h0[1], h0[2], h0[3]}, o[d0], 0, 0, 0); \
        o[d0] = __builtin_amdgcn_mfma_f32_32x32x16_bf16(pa1, (bf16x8){l1[0], l1[1], l1[2], l1[3], h1[0], h1[1], h1[2], h1[3]}, o[d0], 0, 0, 0); \
        o[d0] = __builtin_amdgcn_mfma_f32_32x32x16_bf16(pa2, (bf16x8){l2[0], l2[1], l2[2], l2[3], h2[0], h2[1], h2[2], h2[3]}, o[d0], 0, 0, 0); \
        o[d0] = __builtin_amdgcn_mfma_f32_32x32x16_bf16(pa3, (bf16x8){l3[0], l3[1], l3[2], l3[3], h3[0], h3[1], h3[2], h3[3]}, o[d0], 0, 0, 0); } while (0)
    PV_D0(0); PV_D0(1); PV_D0(2); PV_D0(3);
#undef PV_D0
#undef TRRD
}
template <int DQK, bool CAUSAL>
__device__ __forceinline__ void attn_unit(LAS unsigned char* lds, const bf16_t* Q, int ldq, const bf16_t* Kn, int ldk, const bf16_t* Kr, int ldkr, const bf16_t* V, int ldv,
                                          bf16_t* O, int ldo, int q0, int NT, float C2) {
    constexpr int KROW = DQK * 2, SHM_K = 64 * KROW, ND = DQK / 16;
    int tid = threadIdx.x; asm volatile("" : "+v"(tid));
    const int wid = __builtin_amdgcn_readfirstlane(tid >> 6), lane = tid & 63, r32 = lane & 31, hi = lane >> 5;
    LAS unsigned char* V_lds = lds; LAS unsigned char* K_lds = lds + 2 * SHM_V;
    LAS float* ws = (LAS float*)(lds + 2 * SHM_V + 2 * SHM_K) + wid * 64; LAS float* li_l = ws; LAS float* al_l = ws + 32;
    bf16x8 qr[ND];
#pragma unroll
    for (int d0 = 0; d0 < ND; ++d0) qr[d0] = *(const bf16x8*)(Q + (size_t)(wid * 32 + r32) * ldq + d0 * 16 + hi * 8);
    float m_reg = -1e30f, l_reg = 0.f; f32x16 o[4] = {};
    const int sr = tid >> 4, sc = (tid & 15) * 8, vst0 = v_st(sr, sc), vst1 = v_st(32 + sr, sc);
    const int kws0 = sr * KROW + ((sc * 2) ^ ((sr & 7) << 4)), kws1 = kws0 + 32 * KROW;
    const int rr_ = tid >> 3, rc_ = (tid & 7) * 8, kwsr = rr_ * KROW + ((256 + rc_ * 2) ^ ((rr_ & 7) << 4));
    const int vb0 = (int)(unsigned)(uintptr_t)V_lds + v_rd_base(lane);
    const int qlo = q0 + wid * 32, qm = qlo + r32 - 4 * hi;
    bf16x8 st_v0, st_v1, st_k0, st_k1, st_kr;
#define ATT_LOAD(t) do { const int kb_ = (t) * 64; \
        st_v0 = *(const bf16x8*)(V + (size_t)(kb_ + sr) * ldv + sc); st_v1 = *(const bf16x8*)(V + (size_t)(kb_ + 32 + sr) * ldv + sc); \
        st_k0 = *(const bf16x8*)(Kn + (size_t)(kb_ + sr) * ldk + sc); st_k1 = *(const bf16x8*)(Kn + (size_t)(kb_ + 32 + sr) * ldk + sc); \
        if constexpr (DQK == 192) st_kr = *(const bf16x8*)(Kr + (size_t)(kb_ + rr_) * ldkr + rc_); } while (0)
#define ATT_WRITE(BUF) do { *(LAS bf16x8*)(V_lds + (BUF) * SHM_V + vst0) = st_v0; *(LAS bf16x8*)(V_lds + (BUF) * SHM_V + vst1) = st_v1; \
        *(LAS bf16x8*)(K_lds + (BUF) * SHM_K + kws0) = st_k0; *(LAS bf16x8*)(K_lds + (BUF) * SHM_K + kws1) = st_k1; \
        if constexpr (DQK == 192) *(LAS bf16x8*)(K_lds + (BUF) * SHM_K + kwsr) = st_kr; } while (0)
#define ATT_STEP(BUF, t) do { \
        ATT_WRITE(BUF); __syncthreads(); \
        if ((t) + 1 < NT) ATT_LOAD((t) + 1); \
        f32x16 p0, p1; qkt<BUF, DQK>(p0, p1, K_lds, r32, hi, qr); \
        if constexpr (CAUSAL) { const int kb_ = (t) * 64; if (kb_ + 63 > qlo) mask_tile(p0, p1, qm - kb_); } \
        float mn, alpha; partialSM(p0, p1, m_reg, mn, alpha, C2); \
        if (__any(alpha < 1.f)) { if (hi == 0) al_l[r32] = alpha; asm volatile("s_waitcnt lgkmcnt(0)" ::: "memory"); \
            _Pragma("unroll") for (int d_ = 0; d_ < 4; ++d_) _Pragma("unroll") for (int r = 0; r < 16; ++r) o[d_][r] *= al_l[crow(r, hi)]; } \
        bf16x8 pa0, pa1, pa2, pa3; finishSM(p0, p1, alpha, l_reg, pa0, pa1, pa2, pa3); SBAR(); \
        pv_tile<BUF>(o, vb0, pa0, pa1, pa2, pa3); } while (0)
    ATT_LOAD(0);
    for (int t = 0; t < NT; t += 2) { ATT_STEP(0, t); ATT_STEP(1, t + 1); }
#undef ATT_LOAD
#undef ATT_WRITE
#undef ATT_STEP
    if (hi == 0) li_l[r32] = l_reg; asm volatile("s_waitcnt lgkmcnt(0)" ::: "memory");
    float rli[16];
#pragma unroll
    for (int r = 0; r < 16; ++r) rli[r] = __builtin_amdgcn_rcpf(li_l[crow(r, hi)]);
    bf16_t* Ow = O + (size_t)(wid * 32) * ldo;
#pragma unroll
    for (int r = 0; r < 16; ++r) { const int orow = crow(r, hi);
#pragma unroll
        for (int d0 = 0; d0 < 4; ++d0) { const float v = o[d0][r] * rli[r]; const float vn = __shfl_xor(v, 1);
            if ((r32 & 1) == 0) *(unsigned*)(Ow + (size_t)orow * ldo + d0 * 32 + r32) = cvt_pk_bf16(v, vn); } }
    __syncthreads();
}
#undef SBAR
__constant__ unsigned char MLA_BINS[16][8] = {
    {0x0F, 0x08, 0xFF, 0xFF, 0xFF, 0xFF, 0xFF, 0xFF}, {0x1F, 0x18, 0x00, 0xFF, 0xFF, 0xFF, 0xFF, 0xFF}, {0x2F, 0x09, 0xFF, 0xFF, 0xFF, 0xFF, 0xFF, 0xFF}, {0x0E, 0x19, 0xFF, 0xFF, 0xFF, 0xFF, 0xFF, 0xFF},
    {0x1E, 0x29, 0x10, 0xFF, 0xFF, 0xFF, 0xFF, 0xFF}, {0x2E, 0x0A, 0xFF, 0xFF, 0xFF, 0xFF, 0xFF, 0xFF}, {0x0D, 0x1A, 0xFF, 0xFF, 0xFF, 0xFF, 0xFF, 0xFF}, {0x1D, 0x2A, 0x20, 0xFF, 0xFF, 0xFF, 0xFF, 0xFF},
    {0x2D, 0x0B, 0xFF, 0xFF, 0xFF, 0xFF, 0xFF, 0xFF}, {0x0C, 0x1B, 0xFF, 0xFF, 0xFF, 0xFF, 0xFF, 0xFF}, {0x1C, 0x2B, 0xFF, 0xFF, 0xFF, 0xFF, 0xFF, 0xFF}, {0x2C, 0x28, 0x03, 0xFF, 0xFF, 0xFF, 0xFF, 0xFF},
    {0x07, 0x17, 0x06, 0x01, 0xFF, 0xFF, 0xFF, 0xFF}, {0x27, 0x16, 0x05, 0x13, 0xFF, 0xFF, 0xFF, 0xFF}, {0x26, 0x15, 0x25, 0x23, 0x11, 0xFF, 0xFF, 0xFF}, {0x04, 0x14, 0x24, 0x02, 0x12, 0x22, 0x21, 0xFF}};
}

constexpr size_t MiB = 1u << 20;
constexpr size_t al256(size_t x) { return (x + 255) & ~(size_t)255; }
constexpr size_t WS_CTL = 0, CTL_ZERO_BYTES = 64 * 1024;
constexpr size_t SZ_GU = (size_t)2 * DFF * DM * 2, SZ_DN = (size_t)DM * DFF * 2;
constexpr size_t WS_GU = 1 * MiB, WS_DN = WS_GU + 8 * SZ_GU, WS_WOUT = WS_DN + 8 * SZ_DN;
constexpr size_t WS_MEMW = WS_WOUT + (size_t)4 * DM * DM * 2;
constexpr size_t WS_AIN = WS_MEMW + (size_t)4 * 1024 * DM * 2;
constexpr size_t WS_GLU = WS_AIN + (size_t)2 * DM * DM * 2;
constexpr size_t WS_BIN = WS_GLU + (size_t)2 * TOKW * TOKW * 2;
constexpr size_t WS_UQ = WS_BIN + (size_t)2 * 1024 * DM * 2;
constexpr size_t WS_DKV = WS_UQ + (size_t)2 * NH * DQKH * QRANK * 2;
constexpr size_t WS_UKV = WS_DKV + (size_t)768 * DM * 2;
constexpr size_t WS_TF = WS_UKV + (size_t)3072 * KVRANK * 2;
constexpr size_t WS_GM = WS_TF + (size_t)2 * S5G * 256 * 384 * 2;
constexpr size_t WS_L16 = WS_GM + (size_t)2 * S5G * 256 * 256 * 2;
constexpr size_t WS_COS = WS_L16 + (size_t)2 * S5G * S5P * 2 * 4, WS_SIN = WS_COS + (size_t)M * 32 * 4;
constexpr size_t WS_MEMN = WS_SIN + (size_t)M * 32 * 4;
constexpr size_t WS_MKV = WS_MEMN + (size_t)4 * 1024 * DM * 2;
constexpr size_t WS_HB = WS_MKV + (size_t)4 * 1024 * 1024 * 2;
constexpr size_t WS_FB = WS_HB + (size_t)M * DM * 2;
constexpr size_t WS_CAT = WS_FB + (size_t)M * DM * 2;
constexpr size_t WS_QMEM = WS_CAT + (size_t)M * DM * 2;
constexpr size_t WS_HKV = WS_QMEM + (size_t)M * MEMW * 2;
constexpr size_t WS_CKV = WS_HKV + (size_t)M * DM * 2;
constexpr size_t WS_SSQ = WS_CKV + (size_t)M * KVRANK * 2;
constexpr size_t WS_KR = WS_SSQ + (size_t)2 * M * 8 * 4;
constexpr size_t WS_KN = WS_KR + (size_t)M * DROPE * 2, WS_VV = WS_KN + (size_t)M * TOKW * 2;
constexpr size_t WS_XB = WS_VV + (size_t)M * TOKW * 2;
constexpr size_t WS_ACT = WS_XB + (size_t)M * DM * 2;
constexpr size_t WS_UH = WS_ACT;
constexpr size_t WS_SEND = WS_UH + (size_t)S5G * NCHUNK * 384 * 2;
constexpr size_t WS_Y = WS_SEND + (size_t)S5G * NCHUNK * 128 * 4;
constexpr size_t WS_CQ = WS_ACT, WS_Q = WS_CQ + (size_t)M * QRANK * 2;
constexpr size_t WS_END = WS_ACT + (size_t)M * DFF * 2;
static_assert(WS_Y + (size_t)S5G * NCHUNK * 256 * 2 <= WS_END && WS_Q + (size_t)M * NH * DQKH * 2 <= WS_END, "mixer scratch fits the activation buffer");
static_assert(WS_END <= (size_t)1408 * MiB, "d_ws map");

constexpr int NWAVES = 8;
constexpr int RING_OFF = 0, RING_BYTES = 131072;
constexpr int LDSCTL_OFF = RING_BYTES, MISC_OFF = LDSCTL_OFF + 320;
constexpr int LDS_BYTES = 147456;

typedef GAS unsigned gu32;
#define RLX_AGENT __ATOMIC_RELAXED, __HIP_MEMORY_SCOPE_AGENT
#define LDS_WAIT() asm volatile("s_waitcnt lgkmcnt(0)" ::: "memory")
#define VM_WAIT() asm volatile("s_waitcnt vmcnt(0)" ::: "memory")
__device__ __forceinline__ unsigned f2bf(float f) { unsigned u = __builtin_bit_cast(unsigned, f); return (u + 0x7fffu + ((u >> 16) & 1u)) >> 16; }
__device__ __forceinline__ unsigned pk2(float lo, float hi) { return f2bf(lo) | (f2bf(hi) << 16); }

#define XB_TMO      128
#define XB_XCNT(j)  (256  + 64 * (j))
#define XB_XSUB(j)  (1280 + 64 * (j))
#define XB_XGEN(j)  (2304 + 64 * (j))
#define XB_TOP      3328
#define XB_TOPGEN   3392
#define XCD_BAR_WORDS 3456
#define XB_SPIN_CAP (1u << 18)
__device__ __forceinline__ unsigned xb_ld(unsigned* p)              { return __hip_atomic_load(p, __ATOMIC_RELAXED, __HIP_MEMORY_SCOPE_AGENT); }
__device__ __forceinline__ unsigned xb_add(unsigned* p, unsigned v) { return __hip_atomic_fetch_add(p, v, __ATOMIC_RELAXED, __HIP_MEMORY_SCOPE_AGENT); }
__device__ __forceinline__ unsigned xb_xcc_id() { return (unsigned)__builtin_amdgcn_s_getreg((3 << 11) | 20) & 0xFu; }
#define XB_SPIN(cond, bar) do { unsigned _sp = 0; while (cond) { __builtin_amdgcn_s_sleep(1); \
    if ((++_sp & 255u) == 0u) { if (xb_ld(&(bar)[XB_TMO])) break; if (_sp > XB_SPIN_CAP) { atomicAdd(&(bar)[XB_TMO], 1u); break; } } } } while (0)
struct XcdBarrier { unsigned* bar; unsigned x; volatile LAS unsigned* st; };
__device__ __forceinline__ XcdBarrier xcd_barrier_post(unsigned* bar, volatile LAS unsigned* st) {
    XcdBarrier b; b.bar = bar; b.x = xb_xcc_id(); b.st = st;
    if (threadIdx.x == 0) (void)xb_add(&bar[XB_XCNT(b.x)], 1u);
    return b;
}
__device__ __forceinline__ void xcd_barrier_complete(unsigned* bar, unsigned x, unsigned& nloc, unsigned& nx) {
    const unsigned G = gridDim.x * gridDim.y * gridDim.z;
    unsigned sum, cnt, mine, sp = 0u;
    for (;;) {
        sum = 0u; cnt = 0u; mine = 0u;
#pragma unroll
        for (unsigned j = 0; j < 16; ++j) { const unsigned c = xb_ld(&bar[XB_XCNT(j)]); sum += c; cnt += (c > 0u) ? 1u : 0u; mine = (j == x) ? c : mine; }
        if (sum == G) break;
        __builtin_amdgcn_s_sleep(1);
        if ((++sp & 255u) == 0u) { if (xb_ld(&bar[XB_TMO])) break; if (sp > XB_SPIN_CAP) { atomicAdd(&bar[XB_TMO], 1u); break; } }
    }
    nloc = mine > 0u ? mine : 1u; nx = cnt > 0u ? cnt : 1u;
}
__device__ __forceinline__ void xcd_barrier(const XcdBarrier& b) {
    asm volatile("s_waitcnt vmcnt(0)" ::: "memory");
    __syncthreads();
    if (threadIdx.x == 0) {
        unsigned* bar = b.bar;
        __builtin_amdgcn_s_waitcnt(0);
        unsigned nloc = b.st[0], nx = b.st[1];
        if (nloc == 0u) { xcd_barrier_complete(bar, b.x, nloc, nx); b.st[0] = nloc; b.st[1] = nx; }
        const unsigned old = xb_add(&bar[XB_XSUB(b.x)], 1u);
        const unsigned gen = old / nloc;
        if (old + 1u == (gen + 1u) * nloc) {
            __builtin_amdgcn_fence(__ATOMIC_RELEASE, "agent");
            asm volatile("s_waitcnt vmcnt(0)" ::: "memory");
            const unsigned og = xb_add(&bar[XB_TOP], 1u);
            const unsigned tg = og / nx;
            if (og + 1u == (tg + 1u) * nx) xb_add(&bar[XB_TOPGEN], 1u);
            else XB_SPIN(xb_ld(&bar[XB_TOPGEN]) == tg, bar);
            __builtin_amdgcn_fence(__ATOMIC_ACQUIRE, "agent");
            xb_add(&bar[XB_XGEN(b.x)], 1u);
            asm volatile("s_waitcnt vmcnt(0)" ::: "memory");
        } else {
            XB_SPIN(xb_ld(&bar[XB_XGEN(b.x)]) == gen, bar);
            __builtin_amdgcn_fence(__ATOMIC_ACQUIRE, "agent");
            asm volatile("s_waitcnt vmcnt(0)" ::: "memory");
        }
    }
    __syncthreads();
}

struct Args { const float* in[30]; float* out; unsigned char* wsp; int ph_lo, ph_hi; };
struct Frame {
    LAS unsigned char* lds;
    int tid, lane, wave, vcu, G;
};
__device__ __forceinline__ float wave_sum(float v) {
#pragma unroll
    for (int o = 1; o < 64; o <<= 1) v += __shfl_xor(v, o);
    return v;
}
__device__ __forceinline__ void sincos_d(double a, float& s, float& c) {
    const double n = __builtin_rint(a * 0.63661977236758134308); const float r = (float)(__builtin_fma(-n, 1.57079632679489661923, a) - n * 6.123233995736766e-17);
    const float r2 = r * r;
    const float sp = r * (1.0f + r2 * (-1.6666667e-1f + r2 * (8.3333333e-3f + r2 * (-1.9841270e-4f + r2 * (2.7557319e-6f + r2 * (-2.5052108e-8f))))));
    const float cp = 1.0f + r2 * (-0.5f + r2 * (4.1666667e-2f + r2 * (-1.3888889e-3f + r2 * (2.4801587e-5f + r2 * (-2.7557319e-7f + r2 * 2.0876757e-9f)))));
    const int q = (int)((long long)n & 3);
    const float ss = (q & 1) ? cp : sp, cc = (q & 1) ? sp : cp;
    s = (q & 2) ? -ss : ss; c = ((q + 1) & 2) ? -cc : cc;
}

__constant__ double ROPE_INV_FREQ[32] = {1.0, 0.7498942093324559, 0.5623413251903491, 0.4216965034285822, 0.31622776601683794, 0.23713737056616552, 0.1778279410038923, 0.1333521432163324, 0.1, 0.07498942093324558, 0.05623413251903491, 0.042169650342858224, 0.03162277660168379, 0.023713737056616554, 0.01778279410038923, 0.01333521432163324, 0.01, 0.007498942093324558, 0.005623413251903491, 0.004216965034285823, 0.0031622776601683794, 0.0023713737056616554, 0.0017782794100389228, 0.001333521432163324, 0.001, 0.0007498942093324559, 0.0005623413251903491, 0.00042169650342858224, 0.00031622776601683794, 0.00023713737056616554, 0.00017782794100389227, 0.0001333521432163324};
enum { MAP_PLAIN = 0, MAP_GATE = 1, MAP_UP = 2, MAP_ROPE64 = 3, MAP_UQ = 4 };
__device__ __forceinline__ int rope_pos(int d) { const int half = d >> 5, i = d & 31; return 8 * (i >> 2) + 4 * half + (i & 3); }
__device__ __forceinline__ int map_row(int mode, int n) {
    if (mode == MAP_GATE) return (n >> 7) * 256 + (n & 127);
    if (mode == MAP_UP) return (n >> 7) * 256 + 128 + (n & 127);
    if (mode == MAP_ROPE64) return rope_pos(n);
    if (mode == MAP_UQ) { const int h = n / DQKH, j = n - h * DQKH; return j < DNOPE ? n : h * DQKH + DNOPE + rope_pos(j - DNOPE); }
    return n;
}
__device__ __forceinline__ void transpose_item(const float* W, int K, int N, bf16_t* WT, int ldo, int row_off, int mode, const float* kgain, LAS float* scr, int item, int lane) {
    const int nblk = N / 32, kb = item / nblk, nb = item % nblk, k0 = 64 * kb, n0 = 32 * nb;
#pragma unroll 8
    for (int i = 0; i < 32; ++i) { const int kk = 2 * i + (lane >> 5); scr[kk * 33 + (lane & 31)] = W[(size_t)(k0 + kk) * N + n0 + (lane & 31)]; }
    LDS_WAIT(); asm volatile("" ::: "memory");
    const int c = lane & 7;
    float gk[8];
#pragma unroll
    for (int e = 0; e < 8; ++e) gk[e] = kgain ? kgain[k0 + 8 * c + e] : 1.0f;
#pragma unroll
    for (int j = 0; j < 4; ++j) { const int n = (lane >> 3) + 8 * j; const LAS float* s = scr + (8 * c) * 33 + n;
        u32x4 o; o.x = pk2(s[0 * 33] * gk[0], s[1 * 33] * gk[1]); o.y = pk2(s[2 * 33] * gk[2], s[3 * 33] * gk[3]); o.z = pk2(s[4 * 33] * gk[4], s[5 * 33] * gk[5]); o.w = pk2(s[6 * 33] * gk[6], s[7 * 33] * gk[7]);
        *(GAS u32x4*)(WT + (size_t)(row_off + map_row(mode, n0 + n)) * ldo + k0 + 8 * c) = o; }
    LDS_WAIT(); asm volatile("" ::: "memory");
}
__device__ __forceinline__ void rms_row_to_bf16(const float* xrow, const float* gain, bf16_t* orow, int lane, bf16_t* xbrow = nullptr) {
    f32x4 v[8]; float s = 0.f;
#pragma unroll
    for (int j = 0; j < 4; ++j) { v[2 * j] = *(const f32x4*)(xrow + j * 512 + lane * 8); v[2 * j + 1] = *(const f32x4*)(xrow + j * 512 + lane * 8 + 4); }
    if (xbrow) {
#pragma unroll
        for (int j = 0; j < 4; ++j) *(u32x4*)(xbrow + j * 512 + lane * 8) = pack8(v[2 * j], v[2 * j + 1]); }
#pragma unroll
    for (int j = 0; j < 8; ++j) s += (v[j][0] * v[j][0] + v[j][1] * v[j][1]) + (v[j][2] * v[j][2] + v[j][3] * v[j][3]);
    const float rstd = 1.0f / sqrtf(wave_sum(s) * (1.0f / DM) + EPS);
#pragma unroll
    for (int j = 0; j < 4; ++j) { const f32x4 g0 = *(const f32x4*)(gain + j * 512 + lane * 8), g1 = *(const f32x4*)(gain + j * 512 + lane * 8 + 4);
        *(u32x4*)(orow + j * 512 + lane * 8) = pack8(v[2 * j] * rstd * g0, v[2 * j + 1] * rstd * g1); }
}
__device__ __forceinline__ void s5_precompute_item(const Args& a, unsigned char* ws, LAS unsigned char* lds, int la, int g, int tid) {
    LAS float* lp_re = (LAS float*)lds;
    LAS float* lp_im = lp_re + 17 * 64;
    LAS float* bb_re = lp_im + 17 * 64;
    LAS float* bb_im = bb_re + 64 * 16;
    LAS float* cc_re = bb_im + 64 * 16;
    LAS float* cc_im = cc_re + 16 * 64;
    LAS float* km = cc_im + 16 * 64;
    LAS float* dd = km + 16 * 256;
    const float* lam_re = a.in[11] + (size_t)(la * S5G + g) * S5P; const float* lam_im = a.in[12] + (size_t)(la * S5G + g) * S5P;
    const float* b_re = a.in[13] + (size_t)(la * S5G + g) * S5P * S5C; const float* b_im = a.in[14] + (size_t)(la * S5G + g) * S5P * S5C;
    const float* c_re = a.in[15] + (size_t)(la * S5G + g) * S5C * S5P; const float* c_im = a.in[16] + (size_t)(la * S5G + g) * S5C * S5P;
    const float* dvec = a.in[17] + (size_t)la * TOKW + g * S5C;
    const float dt = expf(a.in[18][la * S5G + g]);
    if (tid < 64) { const int p = tid; const float lr = lam_re[p], li = lam_im[p];
        const double ad = (double)lr * (double)dt, bd = (double)li * (double)dt;
        for (int j = 0; j <= 16; ++j) { float s, c; sincos_d(bd * j, s, c); const float mag = expf((float)(ad * j)); lp_re[j * 64 + p] = mag * c; lp_im[j * 64 + p] = mag * s; }
        float sb, cb, sh, ch; sincos_d(bd, sb, cb); sincos_d(0.5 * bd, sh, ch); (void)ch;
        const float af = (float)ad; const float em1 = af * (1.f + af * (0.5f + af * (1.f / 6 + af * (1.f / 24 + af * (1.f / 120 + af * (1.f / 720))))));
        const float xr = em1 * cb - 2.f * sh * sh, xi = (em1 + 1.f) * sb;
        const float den = 1.f / (lr * lr + li * li); const float cr = (xr * lr + xi * li) * den, ci = (xi * lr - xr * li) * den;
        for (int c = 0; c < 16; ++c) { const float br = b_re[p * 16 + c], bi = b_im[p * 16 + c]; bb_re[p * 16 + c] = cr * br - ci * bi; bb_im[p * 16 + c] = cr * bi + ci * br; }
        float* l16 = (float*)(ws + WS_L16) + ((size_t)(la * S5G + g) * S5P + p) * 2; l16[0] = lp_re[16 * 64 + p]; l16[1] = lp_im[16 * 64 + p];
    }
    for (int i = tid; i < 1024; i += 512) { cc_re[i] = c_re[i]; cc_im[i] = c_im[i]; }
    if (tid < 16) dd[tid] = dvec[tid];
    __syncthreads();
    for (int e = tid; e < 4096; e += 512) { const int j = e >> 8, co = (e >> 4) & 15, ci = e & 15; float s = 0.f;
        for (int p = 0; p < 64; ++p) { const float zr = cc_re[co * 64 + p] * lp_re[j * 64 + p] - cc_im[co * 64 + p] * lp_im[j * 64 + p], zi = cc_re[co * 64 + p] * lp_im[j * 64 + p] + cc_im[co * 64 + p] * lp_re[j * 64 + p];
            s += zr * bb_re[p * 16 + ci] - zi * bb_im[p * 16 + ci]; }
        km[e] = s; }
    __syncthreads();
    bf16_t* TF = (bf16_t*)(ws + WS_TF) + ((size_t)(la * S5G + g) * 256) * 384;
    for (int pc = tid; pc < 256 * 48; pc += 512) { const int n = pc / 48, k0 = (pc % 48) * 8, to = n >> 4, co = n & 15; float v[8];
        if (k0 < 256) { const int ti = k0 >> 4, ci0 = k0 & 15, j = to - ti;
#pragma unroll
            for (int e = 0; e < 8; ++e) v[e] = j >= 0 ? km[(j * 16 + co) * 16 + ci0 + e] + ((j == 0 && ci0 + e == co) ? dd[co] : 0.f) : 0.f; }
        else { const int im = k0 >= 320, p0 = (k0 - 256) & 63;
#pragma unroll
            for (int e = 0; e < 8; ++e) { const int p = p0 + e; const float cr = cc_re[co * 64 + p], ci = cc_im[co * 64 + p], lr = lp_re[(to + 1) * 64 + p], li = lp_im[(to + 1) * 64 + p];
                v[e] = im ? -(cr * li + ci * lr) : (cr * lr - ci * li); } }
        u32x4 o; o.x = pk2(v[0], v[1]); o.y = pk2(v[2], v[3]); o.z = pk2(v[4], v[5]); o.w = pk2(v[6], v[7]);
        *(GAS u32x4*)(TF + (size_t)n * 384 + k0) = o; }
    bf16_t* GMo = (bf16_t*)(ws + WS_GM) + ((size_t)(la * S5G + g) * 256) * 256;
    for (int pc = tid; pc < 256 * 32; pc += 512) { const int q = pc >> 5, k0 = (pc & 31) * 8, t = k0 >> 4, c0 = k0 & 15; float v[8];
        if (q < 128) { const int p = q & 63, im = q >> 6; const float lr = lp_re[(15 - t) * 64 + p], li = lp_im[(15 - t) * 64 + p];
#pragma unroll
            for (int e = 0; e < 8; ++e) { const float br = bb_re[p * 16 + c0 + e], bi = bb_im[p * 16 + c0 + e]; v[e] = im ? (lr * bi + li * br) : (lr * br - li * bi); } }
        else {
#pragma unroll
            for (int e = 0; e < 8; ++e) v[e] = 0.f; }
        u32x4 o; o.x = pk2(v[0], v[1]); o.y = pk2(v[2], v[3]); o.z = pk2(v[4], v[5]); o.w = pk2(v[6], v[7]);
        *(GAS u32x4*)(GMo + (size_t)q * 256 + k0) = o; }
    __syncthreads();
}
__device__ __forceinline__ void p0_prologue(const Args& a, Frame& F) {
    unsigned char* ws = a.wsp;
    for (int it = F.vcu; it < NA * S5G; it += F.G) s5_precompute_item(a, ws, F.lds, it / S5G, it % S5G, F.tid);
    LAS float* scr = (LAS float*)(F.lds + RING_OFF + F.wave * 16384);
    const int gw = F.vcu * NWAVES + F.wave, NGW = F.G * NWAVES;
    constexpr int I_FF = (DM / 64) * (DFF / 32), I_DN = (DFF / 64) * (DM / 32), I_WO = (DM / 64) * (DM / 32), I_MK = (DM / 64) * (1024 / 32), I_AI = I_WO, I_GL = (TOKW / 64) * (TOKW / 32),
                  I_BI = I_MK, I_UQ = (QRANK / 64) * (NH * DQKH / 32), I_DK = (DM / 64) * (KVRANK / 32), I_KR = (DM / 64) * (DROPE / 32), I_UK = (KVRANK / 64) * (TOKW / 32);
    constexpr int NITEMS = 8 * I_FF * 2 + 8 * I_DN + 4 * I_WO + 4 * I_MK + 2 * I_AI + 2 * I_GL + 2 * I_BI + 2 * I_UQ + I_DK + I_KR + 2 * I_UK;
    for (int it = gw; it < NITEMS; it += NGW) {
        int r = it;
        if (r < 8 * I_FF) { const int f = r / I_FF; transpose_item(a.in[4] + (size_t)f * DM * DFF, DM, DFF, (bf16_t*)(ws + WS_GU + f * SZ_GU), DM, 0, MAP_GATE, nullptr, scr, r % I_FF, F.lane); continue; } r -= 8 * I_FF;
        if (r < 8 * I_FF) { const int f = r / I_FF; transpose_item(a.in[5] + (size_t)f * DM * DFF, DM, DFF, (bf16_t*)(ws + WS_GU + f * SZ_GU), DM, 0, MAP_UP, nullptr, scr, r % I_FF, F.lane); continue; } r -= 8 * I_FF;
        if (r < 8 * I_DN) { const int f = r / I_DN; transpose_item(a.in[6] + (size_t)f * DFF * DM, DFF, DM, (bf16_t*)(ws + WS_DN + f * SZ_DN), DFF, 0, MAP_PLAIN, nullptr, scr, r % I_DN, F.lane); continue; } r -= 8 * I_DN;
        if (r < 4 * I_WO) { const int f = r / I_WO; transpose_item(a.in[7] + (size_t)f * DM * DM, DM, DM, (bf16_t*)(ws + WS_WOUT) + (size_t)f * DM * DM, DM, 0, MAP_PLAIN, nullptr, scr, r % I_WO, F.lane); continue; } r -= 4 * I_WO;
        if (r < 4 * I_MK) { const int f = r / I_MK; transpose_item(a.in[9] + (size_t)f * DM * 1024, DM, 1024, (bf16_t*)(ws + WS_MEMW) + (size_t)f * 1024 * DM, DM, 0, MAP_PLAIN, nullptr, scr, r % I_MK, F.lane); continue; } r -= 4 * I_MK;
        if (r < 2 * I_AI) { const int f = r / I_AI; transpose_item(a.in[10] + (size_t)f * DM * DM, DM, DM, (bf16_t*)(ws + WS_AIN) + (size_t)f * DM * DM, DM, 0, MAP_PLAIN, nullptr, scr, r % I_AI, F.lane); continue; } r -= 2 * I_AI;
        if (r < 2 * I_GL) { const int f = r / I_GL; transpose_item(a.in[19] + (size_t)f * TOKW * TOKW, TOKW, TOKW, (bf16_t*)(ws + WS_GLU) + (size_t)f * TOKW * TOKW, TOKW, 0, MAP_PLAIN, nullptr, scr, r % I_GL, F.lane); continue; } r -= 2 * I_GL;
        if (r < 2 * I_BI) { const int f = r / I_BI; transpose_item(a.in[21] + (size_t)f * DM * 1024, DM, 1024, (bf16_t*)(ws + WS_BIN) + (size_t)f * 1024 * DM, DM, 0, MAP_PLAIN, nullptr, scr, r % I_BI, F.lane); continue; } r -= 2 * I_BI;
        if (r < 2 * I_UQ) { const int f = r / I_UQ; transpose_item(a.in[23] + (size_t)f * QRANK * NH * DQKH, QRANK, NH * DQKH, (bf16_t*)(ws + WS_UQ) + (size_t)f * NH * DQKH * QRANK, QRANK, 0, MAP_UQ, a.in[22] + f * QRANK, scr, r % I_UQ, F.lane); continue; } r -= 2 * I_UQ;
        if (r < I_DK) { transpose_item(a.in[25], DM, KVRANK, (bf16_t*)(ws + WS_DKV), DM, 0, MAP_PLAIN, nullptr, scr, r, F.lane); continue; } r -= I_DK;
        if (r < I_KR) { transpose_item(a.in[29], DM, DROPE, (bf16_t*)(ws + WS_DKV), DM, KVRANK, MAP_ROPE64, nullptr, scr, r, F.lane); continue; } r -= I_KR;
        if (r < I_UK) { transpose_item(a.in[27], KVRANK, TOKW, (bf16_t*)(ws + WS_UKV), KVRANK, 0, MAP_PLAIN, a.in[26], scr, r, F.lane); continue; } r -= I_UK;
        transpose_item(a.in[28], KVRANK, TOKW, (bf16_t*)(ws + WS_UKV), KVRANK, TOKW, MAP_PLAIN, a.in[26], scr, r, F.lane);
    }
    for (int m = gw; m < M; m += NGW) rms_row_to_bf16(a.in[0] + (size_t)m * DM, a.in[3], (bf16_t*)(ws + WS_HB) + (size_t)m * DM, F.lane, (bf16_t*)(ws + WS_XB) + (size_t)m * DM);
    for (int m = gw; m < 4 * 1024; m += NGW) { const int l = m >> 10, r = m & 1023; rms_row_to_bf16(a.in[1] + (size_t)r * DM, a.in[8] + l * DM, (bf16_t*)(ws + WS_MEMN) + (size_t)m * DM, F.lane); }
    const int* pos = (const int*)a.in[2];
    for (int e = (F.vcu * 512 + F.tid); e < M * 32; e += F.G * 512) { const int tok = e >> 5, i = e & 31;
        const double inv = ROPE_INV_FREQ[i];
        float s, c; sincos_d((double)pos[tok] * inv, s, c); ((float*)(ws + WS_COS))[e] = c; ((float*)(ws + WS_SIN))[e] = s; }
}
__device__ __forceinline__ void thin_phase(Frame& F, const bf16_t* fsrc, const bf16_t* xbsrc, bf16_t* xbdst, float* xout, const float* gpost, float scale, const float* gnext, bf16_t* hb, const float* gkv, bf16_t* hkv) {
    const int gw = F.vcu * NWAVES + F.wave, NGW = F.G * NWAVES, lane = F.lane;
    for (int m = gw; m < M; m += NGW) {
        const bf16_t* fr = fsrc + (size_t)m * DM; const bf16_t* xr = xbsrc + (size_t)m * DM;
        float f[32]; float xv[32]; f32x4 x[8];
#pragma unroll
        for (int j = 0; j < 4; ++j) { unpack8(*(const u32x4*)(fr + j * 512 + lane * 8), f + 8 * j); unpack8(*(const u32x4*)(xr + j * 512 + lane * 8), xv + 8 * j); }
#pragma unroll
        for (int j = 0; j < 8; ++j) x[j] = (f32x4){xv[4 * j], xv[4 * j + 1], xv[4 * j + 2], xv[4 * j + 3]};
        float s = 0.f;
#pragma unroll
        for (int j = 0; j < 32; ++j) s += f[j] * f[j];
        const float rf = scale / sqrtf(wave_sum(s) * (1.0f / DM) + EPS);
        float s2 = 0.f;
#pragma unroll
        for (int j = 0; j < 4; ++j) { const f32x4 g0 = *(const f32x4*)(gpost + j * 512 + lane * 8), g1 = *(const f32x4*)(gpost + j * 512 + lane * 8 + 4);
#pragma unroll
            for (int e = 0; e < 4; ++e) { x[2 * j][e] += f[8 * j + e] * rf * g0[e]; x[2 * j + 1][e] += f[8 * j + 4 + e] * rf * g1[e]; }
            if (xout) { *(f32x4*)(xout + (size_t)m * DM + j * 512 + lane * 8) = x[2 * j]; *(f32x4*)(xout + (size_t)m * DM + j * 512 + lane * 8 + 4) = x[2 * j + 1]; }
            else *(u32x4*)(xbdst + (size_t)m * DM + j * 512 + lane * 8) = pack8(x[2 * j], x[2 * j + 1]);
            s2 += (x[2 * j][0] * x[2 * j][0] + x[2 * j][1] * x[2 * j][1]) + (x[2 * j][2] * x[2 * j][2] + x[2 * j][3] * x[2 * j][3]);
            s2 += (x[2 * j + 1][0] * x[2 * j + 1][0] + x[2 * j + 1][1] * x[2 * j + 1][1]) + (x[2 * j + 1][2] * x[2 * j + 1][2] + x[2 * j + 1][3] * x[2 * j + 1][3]); }
        if (gnext || gkv) {
            const float rx = 1.0f / sqrtf(wave_sum(s2) * (1.0f / DM) + EPS);
            if (gnext) {
#pragma unroll
                for (int j = 0; j < 4; ++j) { const f32x4 g0 = *(const f32x4*)(gnext + j * 512 + lane * 8), g1 = *(const f32x4*)(gnext + j * 512 + lane * 8 + 4);
                    *(u32x4*)(hb + (size_t)m * DM + j * 512 + lane * 8) = pack8(x[2 * j] * rx * g0, x[2 * j + 1] * rx * g1); } }
            if (gkv) {
#pragma unroll
                for (int j = 0; j < 4; ++j) { const f32x4 g0 = *(const f32x4*)(gkv + j * 512 + lane * 8), g1 = *(const f32x4*)(gkv + j * 512 + lane * 8 + 4);
                    *(u32x4*)(hkv + (size_t)m * DM + j * 512 + lane * 8) = pack8(x[2 * j] * rx * g0, x[2 * j + 1] * rx * g1); } }
        }
    }
}
__device__ __forceinline__ void s5_scan_phase(Frame& F, unsigned char* ws, int la) {
    const int gw = F.vcu * NWAVES + F.wave, NGW = F.G * NWAVES, p = F.lane;
    const float* SE = (const float*)(ws + WS_SEND); bf16_t* UH = (bf16_t*)(ws + WS_UH);
    for (int it = gw; it < BATCH * S5G; it += NGW) { const int b = it / S5G, g = it % S5G;
        const float* l16 = (const float*)(ws + WS_L16) + ((size_t)(la * S5G + g) * S5P + p) * 2; const float ar = l16[0], ai = l16[1];
        float hr = 0.f, hi = 0.f; const size_t row0 = (size_t)g * NCHUNK + (size_t)b * CPB;
        for (int k0 = 0; k0 < CPB; k0 += 16) { float sr[16], si[16];
#pragma unroll
            for (int k = 0; k < 16; ++k) { sr[k] = SE[(row0 + k0 + k) * 128 + p]; si[k] = SE[(row0 + k0 + k) * 128 + 64 + p]; }
#pragma unroll
            for (int k = 0; k < 16; ++k) { bf16_t* u = UH + (row0 + k0 + k) * 384 + 256; u[p] = (bf16_t)f2bf(hr); u[64 + p] = (bf16_t)f2bf(hi);
                const float nr = ar * hr - ai * hi + sr[k], ni = ar * hi + ai * hr + si[k]; hr = nr; hi = ni; } }
    }
}

__global__ void __launch_bounds__(NWAVES * 64, 2) trunk_fwd(Args args) {
    extern __shared__ __attribute__((aligned(16))) unsigned char lds_raw[];
    Frame F;
    F.lds = (LAS unsigned char*)lds_raw;
    F.tid = threadIdx.x; F.lane = F.tid & 63; F.wave = __builtin_amdgcn_readfirstlane(F.tid >> 6);
    F.G = gridDim.x; { const int bx = blockIdx.x; F.vcu = (F.G % 8 == 0) ? (bx % 8) * (F.G / 8) + bx / 8 : bx; }
    GAS unsigned char* wsg = (GAS unsigned char*)args.wsp;
#define ws ((unsigned char*)wsg)
    volatile LAS unsigned* MISC = (volatile LAS unsigned*)(F.lds + MISC_OFF);
    for (int u = F.tid; u < (LDS_BYTES - LDSCTL_OFF) / 4; u += NWAVES * 64) ((LAS unsigned*)(F.lds + LDSCTL_OFF))[u] = 0u;
    __syncthreads();
    if (!MK_PER_PHASE) (void)xcd_barrier_post((unsigned*)(ws + WS_CTL) + 1024, MISC + 8);
    const int lo = args.ph_lo, hi = args.ph_hi; int pid = 0;
#define PH_ON() (pid >= lo && pid < hi)
#define PH_FRESH() do { int t_ = threadIdx.x; asm volatile("" : "+v"(t_)); F.tid = t_; F.lane = t_ & 63; F.wave = __builtin_amdgcn_readfirstlane(t_ >> 6); wsg = (GAS unsigned char*)args.wsp; asm volatile("" : "+s"(wsg)); } while (0)
#define PH_BAR() do { if (!MK_PER_PHASE && pid >= lo && pid + 1 < hi) { XcdBarrier bar_; bar_.bar = (unsigned*)(ws + WS_CTL) + 1024; bar_.x = xb_xcc_id(); bar_.st = (volatile LAS unsigned*)(F.lds + MISC_OFF) + 8; xcd_barrier(bar_); } PH_FRESH(); } while (0)
#define PH_LOOP(k) for (int rep_ = 0; rep_ <= REPG(k); ++rep_, ({ PH_BAR(); }))
#define PH_LOOP_NB(k) for (int rep_ = 0; rep_ <= REPG(k); ++rep_)
#define PH_END() do { ++pid; } while (0)
#define bx ((int)blockIdx.x)
#define X (args.out)
#define HB ((bf16_t*)(ws + WS_HB))
#define XB ((bf16_t*)(ws + WS_XB))
#define FB ((bf16_t*)(ws + WS_FB))
#define ACT ((bf16_t*)(ws + WS_ACT))
#define CAT ((bf16_t*)(ws + WS_CAT))
#define QMEM ((bf16_t*)(ws + WS_QMEM))

    for (int pass_ = 0; pass_ < NPASS; ++pass_) { PH_FRESH();
    PH_LOOP(0) if (EN(0) && PH_ON()) p0_prologue(args, F);
    PH_END();
    PH_LOOP(1) if (EN(1) && PH_ON()) { pg8::Gemm g{(const bf16_t*)(ws + WS_MEMN), (const bf16_t*)(ws + WS_MEMW), DM, DM, DM}; pg8::MemKvOrder S{F.G, bx}; pg8::EpiMemKv E{(bf16_t*)(ws + WS_MKV)};
        pg8::gemm_phase<pg8::EpiMemKv, pg8::MemKvOrder>(F.lds + RING_OFF, g, S, E); }
    PH_END();

    for (int hl = 0; hl < 2 * DEPTH; ++hl) {
        const int l = hl >> 1, s = hl & 1, ff = l * 2 + s;
#define gl (args.in[3] + (size_t)l * 6 * DM)
        PH_LOOP(2) if (EN(2) && PH_ON()) { pg8::Gemm g{HB, (const bf16_t*)(ws + WS_GU + ff * SZ_GU), DM, DM, DM}; pg8::StaticOrder S; S.init(M / 256, 2 * DFF / 256, F.G, bx); pg8::EpiSwiGLU E{ACT};
            pg8::gemm_phase<pg8::EpiSwiGLU, pg8::StaticOrder>(F.lds + RING_OFF, g, S, E); }
        PH_END();
        PH_LOOP(3) if (EN(3) && PH_ON()) { pg8::Gemm g{ACT, (const bf16_t*)(ws + WS_DN + ff * SZ_DN), DFF, DFF, DFF}; pg8::StaticOrder S; S.init(M / 256, DM / 256, F.G, bx); pg8::EpiBf16 E{FB, DM};
            pg8::gemm_phase<pg8::EpiBf16, pg8::StaticOrder>(F.lds + RING_OFF, g, S, E); }
        PH_END();
        PH_LOOP(4) if (EN(4) && PH_ON()) {
            const float* gnext = s == 0 ? gl + 2 * DM : (l + 1 < DEPTH ? args.in[3] + (size_t)(l + 1) * 6 * DM : nullptr);
            const float* gkv = (s == 1 && l == NA - 1) ? args.in[24] : nullptr;
            const bool fin = (hl == 2 * DEPTH - 1);
            thin_phase(F, FB, XB, rep_ ? (bf16_t*)(ws + WS_ACT) : XB, fin ? X : nullptr, gl + (s == 0 ? 1 : 5) * DM, 0.5f, gnext, rep_ ? CAT : HB, rep_ ? nullptr : gkv, (bf16_t*)(ws + WS_HKV)); }
        PH_END();
        if (s == 0) {
#define MK ((const bf16_t*)(ws + WS_MKV) + (size_t)l * 1024 * 1024)
            if (l < NA) {
                PH_LOOP(5) if (EN(5) && PH_ON()) { pg8::Gemm g{HB, (const bf16_t*)(ws + WS_AIN) + (size_t)l * DM * DM, DM, DM, DM}; pg8::StaticOrder S; S.init(M / 256, DM / 256, F.G, bx); pg8::EpiAin E{(bf16_t*)(ws + WS_UH), QMEM};
                    pg8::gemm_phase<pg8::EpiAin, pg8::StaticOrder>(F.lds + RING_OFF, g, S, E); }
                PH_END();
                PH_LOOP(6) if (EN(6) && PH_ON()) { pg8::Gemm g{(const bf16_t*)(ws + WS_UH), (const bf16_t*)(ws + WS_GM) + (size_t)l * S5G * 256 * 256, 256, 384, 256}; pg8::S5Order S{F.G, bx}; pg8::EpiS5State E{(float*)(ws + WS_SEND)};
                    pg8::gemm_phase<pg8::EpiS5State, pg8::S5Order>(F.lds + RING_OFF, g, S, E); }
                PH_END();
                PH_LOOP(7) if (EN(7) && PH_ON()) s5_scan_phase(F, ws, l);
                PH_END();
                PH_LOOP(6) if (EN(6) && PH_ON()) { pg8::Gemm g{(const bf16_t*)(ws + WS_UH), (const bf16_t*)(ws + WS_TF) + (size_t)l * S5G * 256 * 384, 384, 384, 384}; pg8::S5Order S{F.G, bx}; pg8::EpiS5Out E{(bf16_t*)(ws + WS_Y)};
                    pg8::gemm_phase<pg8::EpiS5Out, pg8::S5Order>(F.lds + RING_OFF, g, S, E); }
                PH_END();
                PH_LOOP_NB(8) if (EN(8) && PH_ON()) { pg8::Gemm g{(const bf16_t*)(ws + WS_Y), (const bf16_t*)(ws + WS_GLU) + (size_t)l * TOKW * TOKW, TOKW, 0, TOKW}; pg8::StaticOrder S; S.init(M / 256, TOKW / 256, F.G, bx);
                    pg8::EpiGlu E{(const bf16_t*)(ws + WS_Y), args.in[20] + (size_t)l * TOKW, CAT};
                    pg8::gemm_phase<pg8::EpiGlu, pg8::StaticOrder, 1>(F.lds + RING_OFF, g, S, E); }
            } else {
                const int j = l - NA;
                PH_LOOP(9) if (EN(9) && PH_ON()) { pg8::Gemm g{HB, (const bf16_t*)(ws + WS_BIN) + (size_t)j * 1024 * DM, DM, DM, DM}; pg8::StaticOrder S; S.init(M / 256, 1024 / 256, F.G, bx);
                    pg8::EpiBin E{(bf16_t*)(ws + WS_CQ), (float*)(ws + WS_SSQ), QMEM};
                    pg8::gemm_phase<pg8::EpiBin, pg8::StaticOrder>(F.lds + RING_OFF, g, S, E); }
                PH_END();
                PH_LOOP(9) if (EN(9) && PH_ON()) { pg8::Gemm g{(const bf16_t*)(ws + WS_CQ), (const bf16_t*)(ws + WS_UQ) + (size_t)j * NH * DQKH * QRANK, QRANK, QRANK, QRANK}; pg8::StaticOrder S; S.init(M / 256, NH * DQKH / 256, F.G, bx);
                    pg8::EpiUq E{(const float*)(ws + WS_SSQ), (const float*)(ws + WS_COS), (const float*)(ws + WS_SIN), (bf16_t*)(ws + WS_Q)};
                    pg8::gemm_phase<pg8::EpiUq, pg8::StaticOrder>(F.lds + RING_OFF, g, S, E); }
                PH_END();
                PH_LOOP_NB(10) if (EN(10) && PH_ON()) {
                    for (int it = F.vcu; it < 256; it += F.G) { const int tri = it >> 4, bin = it & 15;
                        for (int e = 0; e < 8; ++e) { const unsigned code = att::MLA_BINS[bin][e]; if (code == 0xFFu) break;
                            const int bh = tri * 3 + (int)(code >> 4), qb = (int)(code & 15), b = bh / NH, h = bh % NH; const size_t tok0 = (size_t)b * SEQ;
                            att::attn_unit<192, true>(F.lds + RING_OFF, (const bf16_t*)(ws + WS_Q) + (tok0 + qb * 256) * (NH * DQKH) + h * DQKH, NH * DQKH,
                                (const bf16_t*)(ws + WS_KN) + tok0 * TOKW + h * DNOPE, TOKW, (const bf16_t*)(ws + WS_KR) + tok0 * DROPE, DROPE,
                                (const bf16_t*)(ws + WS_VV) + tok0 * TOKW + h * DVH, TOKW, CAT + (tok0 + qb * 256) * DM + h * DVH, DM, qb * 256, 4 * (qb + 1), 0.07216878364870322f * 1.4426950408889634f); } }
                }
            }
            PH_LOOP(11) if (EN(11) && PH_ON()) {
                for (int it = F.vcu; it < BATCH * 4 * (SEQ / 256); it += F.G) { const int b = it >> 6, h = (it >> 4) & 3, qb = it & 15; const size_t tok0 = (size_t)b * SEQ + qb * 256;
                    att::attn_unit<128, false>(F.lds + RING_OFF, QMEM + tok0 * MEMW + h * 128, MEMW, MK + (size_t)b * NMEM * 1024 + h * 128, 1024, nullptr, 0,
                        MK + (size_t)b * NMEM * 1024 + MEMW + h * 128, 1024, CAT + tok0 * DM + TOKW + h * 128, DM, 0, NMEM / 64, 0.08838834764831845f * 1.4426950408889634f); }
            }
            PH_END();
            PH_LOOP(12) if (EN(12) && PH_ON()) { pg8::Gemm g{CAT, (const bf16_t*)(ws + WS_WOUT) + (size_t)l * DM * DM, DM, DM, DM}; pg8::StaticOrder S; S.init(M / 256, DM / 256, F.G, bx); pg8::EpiBf16 E{FB, DM};
                pg8::gemm_phase<pg8::EpiBf16, pg8::StaticOrder>(F.lds + RING_OFF, g, S, E); }
            PH_END();
            PH_LOOP(4) if (EN(4) && PH_ON()) thin_phase(F, FB, XB, rep_ ? (bf16_t*)(ws + WS_ACT) : XB, nullptr, gl + 3 * DM, 1.0f, gl + 4 * DM, rep_ ? CAT : HB, nullptr, nullptr);
            PH_END();
        } else if (l == NA - 1) {
            PH_LOOP(13) if (EN(13) && PH_ON()) { pg8::Gemm g{(const bf16_t*)(ws + WS_HKV), (const bf16_t*)(ws + WS_DKV), DM, DM, DM}; pg8::StaticOrder S; S.init(M / 256, 3, F.G, bx);
                pg8::EpiDkv E{(bf16_t*)(ws + WS_CKV), (float*)(ws + WS_SSQ) + (size_t)M * 8, (const float*)(ws + WS_COS), (const float*)(ws + WS_SIN), (bf16_t*)(ws + WS_KR)};
                pg8::gemm_phase<pg8::EpiDkv, pg8::StaticOrder>(F.lds + RING_OFF, g, S, E); }
            PH_END();
            PH_LOOP(13) if (EN(13) && PH_ON()) { pg8::Gemm g{(const bf16_t*)(ws + WS_CKV), (const bf16_t*)(ws + WS_UKV), KVRANK, KVRANK, KVRANK}; pg8::StaticOrder S; S.init(M / 256, 3072 / 256, F.G, bx);
                pg8::EpiUkv E{(const float*)(ws + WS_SSQ) + (size_t)M * 8, (bf16_t*)(ws + WS_KN), (bf16_t*)(ws + WS_VV)};
                pg8::gemm_phase<pg8::EpiUkv, pg8::StaticOrder>(F.lds + RING_OFF, g, S, E); }
            PH_END();
        }
    }
    }
#undef PH_ON
#undef PH_END
#undef PH_BAR
#undef PH_LOOP
#undef PH_LOOP_NB
#undef ws
#undef bx
#undef X
#undef HB
#undef XB
#undef FB
#undef ACT
#undef CAT
#undef QMEM
#undef gl
#undef MK
}
constexpr int N_PHASES = 2 + 8 * 3 + 2 * 7 + 2 * 5 + 2;

extern "C" void kernel_launch(void* const* d_in, const int* in_sizes, int n_in, void* d_out, int out_size, void* d_ws, size_t ws_size, hipStream_t stream) {
    static int grid = 0;
    if (grid == 0) {
        if (n_in != 30 || in_sizes[0] != M * DM || out_size != M * DM || ws_size < WS_END) { fprintf(stderr, "kernel_launch: shape / workspace mismatch (n_in %d, in0 %d, out %d, ws %zu, need %zu)\n", n_in, n_in > 0 ? in_sizes[0] : -1, out_size, ws_size, (size_t)WS_END); grid = -1; return; }
        int dev = 0, cus = 0, per_cu = 0;
        if (hipGetDevice(&dev) != hipSuccess || hipDeviceGetAttribute(&cus, hipDeviceAttributeMultiprocessorCount, dev) != hipSuccess) { grid = -1; return; }
        if (hipFuncSetAttribute((const void*)trunk_fwd, hipFuncAttributeMaxDynamicSharedMemorySize, LDS_BYTES) != hipSuccess) { fprintf(stderr, "kernel_launch: hipFuncSetAttribute failed\n"); grid = -1; return; }
        if (hipOccupancyMaxActiveBlocksPerMultiprocessor(&per_cu, (const void*)trunk_fwd, NWAVES * 64, LDS_BYTES) != hipSuccess || per_cu < 1) { fprintf(stderr, "kernel_launch: occupancy query reports %d\n", per_cu); }
        (void)hipGetLastError();
        grid = cus;
    }
    if (grid < 0) return;
    if (hipMemsetAsync((char*)d_ws + WS_CTL, 0, CTL_ZERO_BYTES, stream) != hipSuccess) return;
    Args a{};
    for (int i = 0; i < 30; ++i) a.in[i] = (const float*)d_in[i];
    a.out = (float*)d_out; a.wsp = (unsigned char*)d_ws;
#if MK_PER_PHASE
    for (int p = 0; p < N_PHASES; ++p) { a.ph_lo = p; a.ph_hi = p + 1; hipLaunchKernelGGL(trunk_fwd, dim3(grid), dim3(NWAVES * 64), LDS_BYTES, stream, a); }
#else
    a.ph_lo = 0; a.ph_hi = N_PHASES * NPASS;
    hipLaunchKernelGGL(trunk_fwd, dim3(grid), dim3(NWAVES * 64), LDS_BYTES, stream, a);
#endif
    const hipError_t le = hipPeekAtLastError();
    if (le != hipSuccess) fprintf(stderr, "kernel_launch: launch failed: %s\n", hipGetErrorName(le));
}
```

```cpp
#include <hip/hip_runtime.h>
#include <cstdio>
#include <cstdint>

#ifndef MK_PER_PHASE
#define MK_PER_PHASE 0
#endif

#ifndef EN_MASK
#define EN_MASK 0xFFFF
#endif
#define EN(b) ((EN_MASK >> (b)) & 1)
#ifndef REP_MASK
#define REP_MASK 0
#endif
#define REPG(b) ((REP_MASK >> (b)) & 1)
#ifndef NPASS
#define NPASS 1
#endif
constexpr int DM = 2048, BATCH = 4, SEQ = 4096, M = BATCH * SEQ, DEPTH = 4, NA = 2;
constexpr int NMEM = 256, MEMW = 512, TOKW = 1536, DFF = 5632;
constexpr int S5G = 96, S5P = 64, S5C = 16, S5T = 16, NCHUNK = M / S5T, CPB = SEQ / S5T;
constexpr int QRANK = 512, KVRANK = 512, NH = 12, DNOPE = 128, DROPE = 64, DQKH = 192, DVH = 128;
constexpr float EPS = 1e-6f;
constexpr int YGS = NCHUNK * 256;

#define GAS __attribute__((address_space(1)))
#define LAS __attribute__((address_space(3)))
typedef unsigned short bf16_t;
typedef short bf16x8 __attribute__((ext_vector_type(8)));
typedef short s16x4 __attribute__((ext_vector_type(4)));
typedef float f32x4 __attribute__((ext_vector_type(4)));
typedef float f32x2 __attribute__((ext_vector_type(2)));
typedef float f32x16 __attribute__((ext_vector_type(16)));
typedef unsigned u32x4 __attribute__((ext_vector_type(4)));
typedef unsigned u32x2 __attribute__((ext_vector_type(2)));

__device__ __forceinline__ unsigned cvt_pk_bf16(float lo, float hi) { unsigned r; asm volatile("v_cvt_pk_bf16_f32 %0, %1, %2" : "=v"(r) : "v"(lo), "v"(hi)); return r; }
__device__ __forceinline__ u32x4 pack8(f32x4 a, f32x4 b) { u32x4 w; w.x = cvt_pk_bf16(a[0], a[1]); w.y = cvt_pk_bf16(a[2], a[3]); w.z = cvt_pk_bf16(b[0], b[1]); w.w = cvt_pk_bf16(b[2], b[3]); return w; }
__device__ __forceinline__ float bf2f(unsigned short b) { return __uint_as_float(((unsigned)b) << 16); }
__device__ __forceinline__ void unpack8(u32x4 w, float* o) { o[0] = __uint_as_float(w.x << 16); o[1] = __uint_as_float(w.x & 0xffff0000u); o[2] = __uint_as_float(w.y << 16); o[3] = __uint_as_float(w.y & 0xffff0000u);
    o[4] = __uint_as_float(w.z << 16); o[5] = __uint_as_float(w.z & 0xffff0000u); o[6] = __uint_as_float(w.w << 16); o[7] = __uint_as_float(w.w & 0xffff0000u); }
__device__ __forceinline__ float fast_sigmoid(float v) { return __builtin_amdgcn_rcpf(1.0f + __builtin_amdgcn_exp2f(-1.4426950408889634f * v)); }
__device__ __forceinline__ float gelu_tanh(float v) { const float u = 0.7978845608028654f * (v + 0.044715f * v * v * v); const float t = 1.0f - 2.0f * __builtin_amdgcn_rcpf(__builtin_amdgcn_exp2f(2.885390081777927f * u) + 1.0f); return 0.5f * v * (1.0f + t); }

namespace pg8 {
constexpr int BM = 256, BK = 64, HALF = 128, HTB = HALF * BK * 2, STAGE_BYTES = 8 * HTB, NXCD = 8, WGM = 8;
__host__ __device__ __forceinline__ int lds_byte(int r, int c) { const int st = (r >> 4) * 2 + (c >> 5), rr = r & 15, cc = c & 31, ob = rr * 64 + cc * 2; return st * 1024 + (ob ^ (((ob >> 9) & 1) << 5)); }
__host__ __device__ __forceinline__ void stage_rc(int b, int& R, int& C) { const int st = b / 1024, sb = b % 1024, swz = sb ^ (((sb >> 9) & 1) << 5); R = (st >> 1) * 16 + swz / 64; C = (st & 1) * 32 + (swz % 64) / 2; }
__host__ __device__ __forceinline__ int perm32(int rho) { const int n = rho >> 4, i = rho & 15; return 8 * (i >> 2) + 4 * n + (i & 3); }

struct Unit { int pm, pn; };
struct Gemm { const bf16_t* A; const bf16_t* Bt; int K; int lda; int ldb; };

struct StaticOrder {
    int nM, nN, nwg, G, c;
    __device__ __forceinline__ void init(int nM_, int nN_, int G_, int c_) { nM = nM_; nN = nN_; nwg = nM * nN; G = G_; c = c_; }
    __device__ __forceinline__ bool next(int i, Unit& u) const {
        const long L = (long)i * G + c; if (L >= nwg) return false;
        int wgid = (int)L; { const int q = nwg / NXCD, r = nwg % NXCD, xcd = wgid % NXCD, off = wgid / NXCD; wgid = (xcd < r ? xcd * (q + 1) : r * (q + 1) + (xcd - r) * q) + off; }
        const int nig = WGM * nN, gid = wgid / nig, fm = gid * WGM, gsz = (nM - fm) < WGM ? (nM - fm) : WGM;
        u.pm = fm + ((wgid % nig) % gsz); u.pn = (wgid % nig) / gsz; return true;
    }
};
struct S5Order {
    int G, c;
    __device__ __forceinline__ bool next(int i, Unit& u) const { const int L = i * G + c; if (L >= S5G * 4) return false; u.pm = L; u.pn = L >> 2; return true; }
};
struct MemKvOrder {
    int G, c;
    __device__ __forceinline__ bool next(int i, Unit& u) const { const int L = i * G + c; if (L >= 64) return false; const int l = L >> 4, r = L & 15; u.pm = l * 4 + (r >> 2); u.pn = l * 4 + (r & 3); return true; }
};

struct EpiBf16 {
    static constexpr bool PERM = true;
    bf16_t* O; int ldc;
    __device__ __forceinline__ void operator()(const f32x4 (&acc)[2][2][4][2], const Unit& u, int wr, int wc, int fr, int fq) const {
        const int row0 = u.pm * BM + wr * 64 + fr, col0 = u.pn * BM + wc * 32 + 8 * fq;
#pragma unroll
        for (int ai = 0; ai < 2; ++ai)
#pragma unroll
            for (int m = 0; m < 4; ++m) { bf16_t* rowp = O + (size_t)(row0 + ai * HALF + m * 16) * ldc + col0;
#pragma unroll
                for (int bj = 0; bj < 2; ++bj) *(u32x4*)(rowp + bj * HALF) = pack8(acc[ai][bj][m][0], acc[ai][bj][m][1]); }
    }
};
struct EpiMemKv {
    static constexpr bool PERM = true;
    bf16_t* O;
    __device__ __forceinline__ void operator()(const f32x4 (&acc)[2][2][4][2], const Unit& u, int wr, int wc, int fr, int fq) const {
        const int row0 = u.pm * BM + wr * 64 + fr, col0 = (u.pn & 3) * BM + wc * 32 + 8 * fq;
#pragma unroll
        for (int ai = 0; ai < 2; ++ai)
#pragma unroll
            for (int m = 0; m < 4; ++m) { bf16_t* rowp = O + (size_t)(row0 + ai * HALF + m * 16) * 1024 + col0;
#pragma unroll
                for (int bj = 0; bj < 2; ++bj) *(u32x4*)(rowp + bj * HALF) = pack8(acc[ai][bj][m][0], acc[ai][bj][m][1]); }
    }
};
struct EpiSwiGLU {
    static constexpr bool PERM = true, FUSED = false;
    bf16_t* O; const float* RS;
    static __device__ __forceinline__ f32x2 sw2(f32x2 g, f32x2 u, float c, float r2) {
        const f32x2 m = g * c; f32x2 e; e.x = __builtin_amdgcn_exp2f(m.x); e.y = __builtin_amdgcn_exp2f(m.y);
        const f32x2 d = e + 1.0f; f32x2 r; r.x = __builtin_amdgcn_rcpf(d.x); r.y = __builtin_amdgcn_rcpf(d.y);
        return ((g * u) * r) * r2;
    }
    __device__ __forceinline__ void operator()(const f32x4 (&acc)[2][2][4][2], const Unit& u, int wr, int wc, int fr, int fq) const {
        const int row0 = u.pm * BM + wr * 64 + fr, col0 = u.pn * HALF + wc * 32 + 8 * fq;
#pragma unroll
        for (int ai = 0; ai < 2; ++ai)
#pragma unroll
            for (int m = 0; m < 4; ++m) { bf16_t* rowp = O + (size_t)(row0 + ai * HALF + m * 16) * DFF + col0; const float rs = RS[row0 + ai * HALF + m * 16];
                const float c = -1.4426950408889634f * rs, r2 = rs * rs;
                const f32x4 g0 = acc[ai][0][m][0], g1 = acc[ai][0][m][1], u0 = acc[ai][1][m][0], u1 = acc[ai][1][m][1];
                const f32x2 a = sw2((f32x2){g0[0], g0[1]}, (f32x2){u0[0], u0[1]}, c, r2), b = sw2((f32x2){g0[2], g0[3]}, (f32x2){u0[2], u0[3]}, c, r2);
                const f32x2 cc = sw2((f32x2){g1[0], g1[1]}, (f32x2){u1[0], u1[1]}, c, r2), d = sw2((f32x2){g1[2], g1[3]}, (f32x2){u1[2], u1[3]}, c, r2);
                u32x4 w; w.x = cvt_pk_bf16(a.x, a.y); w.y = cvt_pk_bf16(b.x, b.y); w.z = cvt_pk_bf16(cc.x, cc.y); w.w = cvt_pk_bf16(d.x, d.y);
                *(u32x4*)rowp = w; }
    }
};
struct EpiAin {
    static constexpr bool PERM = true;
    bf16_t* UH; bf16_t* QM; const float* RS;
    __device__ __forceinline__ void operator()(const f32x4 (&acc)[2][2][4][2], const Unit& u, int wr, int wc, int fr, int fq) const {
        const int row0 = u.pm * BM + wr * 64 + fr;
#pragma unroll
        for (int ai = 0; ai < 2; ++ai)
#pragma unroll
            for (int m = 0; m < 4; ++m) { const int row = row0 + ai * HALF + m * 16; const float rs = RS[row];
#pragma unroll
                for (int bj = 0; bj < 2; ++bj) { const int c0 = u.pn * BM + bj * HALF + wc * 32 + 8 * fq; const u32x4 w = pack8(acc[ai][bj][m][0] * rs, acc[ai][bj][m][1] * rs);
                    if (u.pn < 6) *(u32x4*)(UH + ((size_t)(c0 >> 4) * NCHUNK + (row >> 4)) * 384 + (row & 15) * 16 + (c0 & 15)) = w;
                    else *(u32x4*)(QM + (size_t)row * MEMW + (c0 - TOKW)) = w; } }
    }
};
struct EpiS5State {
    static constexpr bool PERM = false;
    float* SE;
    __device__ __forceinline__ void operator()(const f32x4 (&acc)[2][2][4][2], const Unit& u, int wr, int wc, int fr, int fq) const {
        const int row0 = u.pm * BM + wr * 64 + fr, col0 = wc * 32 + 4 * fq;
#pragma unroll
        for (int ai = 0; ai < 2; ++ai)
#pragma unroll
            for (int m = 0; m < 4; ++m) { float* rowp = SE + (size_t)(row0 + ai * HALF + m * 16) * 128 + col0;
#pragma unroll
                for (int n = 0; n < 2; ++n) *(f32x4*)(rowp + n * 16) = acc[ai][0][m][n]; }
    }
};
struct EpiS5Out {
    static constexpr bool PERM = true;
    bf16_t* Y;
    __device__ __forceinline__ void operator()(const f32x4 (&acc)[2][2][4][2], const Unit& u, int wr, int wc, int fr, int fq) const {
        const int row0 = u.pm * BM + wr * 64 + fr, col0 = wc * 32 + 8 * fq;
#pragma unroll
        for (int ai = 0; ai < 2; ++ai)
#pragma unroll
            for (int m = 0; m < 4; ++m) { bf16_t* rowp = Y + (size_t)(row0 + ai * HALF + m * 16) * 256 + col0;
#pragma unroll
                for (int bj = 0; bj < 2; ++bj) { f32x4 v0, v1;
#pragma unroll
                    for (int j = 0; j < 4; ++j) { v0[j] = gelu_tanh(acc[ai][bj][m][0][j]); v1[j] = gelu_tanh(acc[ai][bj][m][1][j]); }
                    *(u32x4*)(rowp + bj * HALF) = pack8(v0, v1); } }
    }
};
struct EpiGlu {
    static constexpr bool PERM = true;
    const bf16_t* Y; const float* bias; bf16_t* CAT;
    __device__ __forceinline__ void operator()(const f32x4 (&acc)[2][2][4][2], const Unit& u, int wr, int wc, int fr, int fq) const {
        const int row0 = u.pm * BM + wr * 64 + fr;
#pragma unroll
        for (int bj = 0; bj < 2; ++bj) { const int c0 = u.pn * BM + bj * HALF + wc * 32 + 8 * fq;
            const f32x4 b0 = *(const f32x4*)(bias + c0), b1 = *(const f32x4*)(bias + c0 + 4);
#pragma unroll
            for (int ai = 0; ai < 2; ++ai)
#pragma unroll
                for (int m = 0; m < 4; ++m) { const int row = row0 + ai * HALF + m * 16;
                    const u32x4 yw = *(const u32x4*)(Y + (size_t)(c0 >> 4) * YGS + (size_t)(row >> 4) * 256 + (row & 15) * 16 + (c0 & 15));
                    float y[8]; unpack8(yw, y); f32x4 v0, v1;
#pragma unroll
                    for (int j = 0; j < 4; ++j) { v0[j] = y[j] * fast_sigmoid(acc[ai][bj][m][0][j] + b0[j]); v1[j] = y[4 + j] * fast_sigmoid(acc[ai][bj][m][1][j] + b1[j]); }
                    *(u32x4*)(CAT + (size_t)row * DM + c0) = pack8(v0, v1); asm volatile("" ::: "memory"); } }
    }
};
__device__ __forceinline__ void ssq_partial(const f32x4 (&acc)[2][2][4][2], int ai, int m, float* SSQ, int row, int pn, int wc, int fq, float rs) {
    float s = 0.f;
#pragma unroll
    for (int bj = 0; bj < 2; ++bj)
#pragma unroll
        for (int n = 0; n < 2; ++n) { const f32x4 x = acc[ai][bj][m][n]; s += (x[0] * x[0] + x[1] * x[1]) + (x[2] * x[2] + x[3] * x[3]); }
    s += __shfl_xor(s, 16); s += __shfl_xor(s, 32);
    if (fq == 0) SSQ[(size_t)row * 8 + pn * 4 + wc] = s * rs * rs;
}
struct EpiBin {
    static constexpr bool PERM = true;
    bf16_t* CQ; float* SSQ; bf16_t* QM; const float* RS;
    __device__ __forceinline__ void operator()(const f32x4 (&acc)[2][2][4][2], const Unit& u, int wr, int wc, int fr, int fq) const {
        const int row0 = u.pm * BM + wr * 64 + fr;
#pragma unroll
        for (int ai = 0; ai < 2; ++ai)
#pragma unroll
            for (int m = 0; m < 4; ++m) { const int row = row0 + ai * HALF + m * 16; const float rs = RS[row];
                if (u.pn < 2) ssq_partial(acc, ai, m, SSQ, row, u.pn, wc, fq, rs);
#pragma unroll
                for (int bj = 0; bj < 2; ++bj) { const int c0 = u.pn * BM + bj * HALF + wc * 32 + 8 * fq; const u32x4 w = pack8(acc[ai][bj][m][0] * rs, acc[ai][bj][m][1] * rs);
                    if (u.pn < 2) *(u32x4*)(CQ + (size_t)row * QRANK + c0) = w; else *(u32x4*)(QM + (size_t)row * MEMW + (c0 - QRANK)) = w; } }
    }
};
__device__ __forceinline__ float rstd_from_ssq(const float* SSQ, int row) { const f32x4 a = *(const f32x4*)(SSQ + (size_t)row * 8), b = *(const f32x4*)(SSQ + (size_t)row * 8 + 4);
    return 1.0f / sqrtf(((a[0] + a[1]) + (a[2] + a[3]) + (b[0] + b[1]) + (b[2] + b[3])) * (1.0f / 512.0f) + EPS); }
__device__ __forceinline__ void rope_store(f32x4 t1, f32x4 t2, const float* cs, const float* sn, int row, int i0, bf16_t* dst  ) {
    const f32x4 c = *(const f32x4*)(cs + (size_t)row * 32 + i0), s = *(const f32x4*)(sn + (size_t)row * 32 + i0);
    const f32x4 o1 = t1 * c - t2 * s, o2 = t1 * s + t2 * c;
    u32x2 w1, w2; w1.x = cvt_pk_bf16(o1[0], o1[1]); w1.y = cvt_pk_bf16(o1[2], o1[3]); w2.x = cvt_pk_bf16(o2[0], o2[1]); w2.y = cvt_pk_bf16(o2[2], o2[3]);
    *(u32x2*)(dst + i0) = w1; *(u32x2*)(dst + 32 + i0) = w2;
}
struct EpiUq {
    static constexpr bool PERM = true;
    const float* SSQ; const float* cs; const float* sn; bf16_t* Q;
    __device__ __forceinline__ void operator()(const f32x4 (&acc)[2][2][4][2], const Unit& u, int wr, int wc, int fr, int fq) const {
        const int row0 = u.pm * BM + wr * 64 + fr;
#pragma unroll
        for (int ai = 0; ai < 2; ++ai)
#pragma unroll
            for (int m = 0; m < 4; ++m) { const int row = row0 + ai * HALF + m * 16; const float rs = rstd_from_ssq(SSQ, row);
#pragma unroll
                for (int bj = 0; bj < 2; ++bj) { const int c0 = u.pn * BM + bj * HALF + wc * 32 + 8 * fq; const int h = c0 / DQKH, j = c0 - h * DQKH;
                    const f32x4 a0 = acc[ai][bj][m][0] * rs, a1 = acc[ai][bj][m][1] * rs;
                    if (j < DNOPE) *(u32x4*)(Q + (size_t)row * (NH * DQKH) + c0) = pack8(a0, a1);
                    else rope_store(a0, a1, cs, sn, row, ((j - DNOPE) >> 3) * 4, Q + (size_t)row * (NH * DQKH) + h * DQKH + DNOPE); }
                asm volatile("" ::: "memory"); }
    }
};
struct EpiDkv {
    static constexpr bool PERM = true;
    bf16_t* CKV; float* SSQ; const float* cs; const float* sn; bf16_t* KR; const float* RS;
    __device__ __forceinline__ void operator()(const f32x4 (&acc)[2][2][4][2], const Unit& u, int wr, int wc, int fr, int fq) const {
        const int row0 = u.pm * BM + wr * 64 + fr;
#pragma unroll
        for (int ai = 0; ai < 2; ++ai)
#pragma unroll
            for (int m = 0; m < 4; ++m) { const int row = row0 + ai * HALF + m * 16; const float rs = RS[row];
                if (u.pn < 2) { ssq_partial(acc, ai, m, SSQ, row, u.pn, wc, fq, rs);
#pragma unroll
                    for (int bj = 0; bj < 2; ++bj) *(u32x4*)(CKV + (size_t)row * KVRANK + u.pn * BM + bj * HALF + wc * 32 + 8 * fq) = pack8(acc[ai][bj][m][0] * rs, acc[ai][bj][m][1] * rs); }
                else if (wc < 2) rope_store(acc[ai][0][m][0] * rs, acc[ai][0][m][1] * rs, cs, sn, row, (wc * 4 + fq) * 4, KR + (size_t)row * DROPE);
                asm volatile("" ::: "memory"); }
    }
};
struct EpiUkv {
    static constexpr bool PERM = true;
    const float* SSQ; bf16_t* KN; bf16_t* VV;
    __device__ __forceinline__ void operator()(const f32x4 (&acc)[2][2][4][2], const Unit& u, int wr, int wc, int fr, int fq) const {
        const int row0 = u.pm * BM + wr * 64 + fr; bf16_t* base = u.pn < 6 ? KN : VV; const int colt = (u.pn < 6 ? u.pn : u.pn - 6) * BM + wc * 32 + 8 * fq;
#pragma unroll
        for (int ai = 0; ai < 2; ++ai)
#pragma unroll
            for (int m = 0; m < 4; ++m) { const int row = row0 + ai * HALF + m * 16; const float rs = rstd_from_ssq(SSQ, row);
#pragma unroll
                for (int bj = 0; bj < 2; ++bj) *(u32x4*)(base + (size_t)row * TOKW + colt + bj * HALF) = pack8(acc[ai][bj][m][0] * rs, acc[ai][bj][m][1] * rs);
                asm volatile("" ::: "memory"); }
    }
};

template <class Epi, class Sched, int AMODE = 0, bool ALIGN_EPI = true>
__device__ __forceinline__ void gemm_phase(LAS unsigned char* lds, const Gemm g, const Sched& S, const Epi& E) {
    int tid = threadIdx.x; asm volatile("" : "+v"(tid));
    const int wid = __builtin_amdgcn_readfirstlane(tid >> 6), lane = tid & 63, wr = wid >> 2, wc = wid & 3, fr = lane & 15, fq = lane >> 4;
    const int nt = g.K / BK;
    unsigned voffA[2], voffB[2];
#pragma unroll
    for (int i = 0; i < 2; ++i) { int R, C; stage_rc(tid * 16 + i * 8192, R, C); const int Rb = Epi::PERM ? ((R & ~31) + perm32(R & 31)) : R;
        if (AMODE == 0) voffA[i] = (unsigned)(R * g.lda + C) * 2u; else voffA[i] = (unsigned)((C >> 4) * YGS + (R >> 4) * 256 + (R & 15) * 16 + (C & 15)) * 2u;
        voffB[i] = (unsigned)(Rb * g.ldb + C) * 2u; }
    const size_t kstepA = AMODE == 0 ? (size_t)(BK * 2) : (size_t)4 * YGS * 2, kstepB = (size_t)(BK * 2);
    const size_t hstepA = AMODE == 0 ? (size_t)HALF * g.lda * 2 : (size_t)8 * 256 * 2, hstepB = (size_t)HALF * g.ldb * 2;
    const size_t tstepA = 2 * hstepA, tstepB = 2 * hstepB;
    const unsigned ldsw = (unsigned)wid * 1024u;
    const int aoff = lds_byte(wr * 64 + fr, fq * 8), boff = lds_byte(wc * 32 + fr, fq * 8);
#define PG8_SA(b, h) (((b) * 2 + (h)) * HTB)
#define PG8_SB(b, h) ((4 + (b) * 2 + (h)) * HTB)
#define PG8_STAGE(bufoff, gbase, voff) do { _Pragma("unroll") for (int _i = 0; _i < 2; ++_i) \
        __builtin_amdgcn_global_load_lds((const unsigned*)((const char*)(gbase) + (voff)[_i]), (LAS unsigned*)(lds + (bufoff) + ldsw + _i * 8192), 16, 0, 0); } while (0)
#define PG8_LDA(dst, b, h) do { _Pragma("unroll") for (int m = 0; m < 4; ++m) _Pragma("unroll") for (int k = 0; k < 2; ++k) dst[m][k] = *(const LAS bf16x8*)(lds + PG8_SA(b, h) + aoff + m * 2048 + k * 1024); } while (0)
#define PG8_LDB(dst, b, h) do { _Pragma("unroll") for (int n = 0; n < 2; ++n) _Pragma("unroll") for (int k = 0; k < 2; ++k) dst[n][k] = *(const LAS bf16x8*)(lds + PG8_SB(b, h) + boff + n * 2048 + k * 1024); } while (0)
#define PG8_MMA(ai, bj, At, Bt) do { __builtin_amdgcn_s_setprio(1); _Pragma("unroll") for (int m = 0; m < 4; ++m) _Pragma("unroll") for (int n = 0; n < 2; ++n) _Pragma("unroll") for (int k = 0; k < 2; ++k) \
        acc[ai][bj][m][n] = __builtin_amdgcn_mfma_f32_16x16x32_bf16(Bt[n][k], At[m][k], acc[ai][bj][m][n], 0, 0, 0); __builtin_amdgcn_s_setprio(0); } while (0)
#define PG8_WAIT_V(n) asm volatile("s_waitcnt vmcnt(" #n ")" ::: "memory")
#define PG8_WAIT_L(n) asm volatile("s_waitcnt lgkmcnt(" #n ")" ::: "memory")
#define PG8_BAR __builtin_amdgcn_s_barrier()
#define PG8_SCHED __builtin_amdgcn_sched_barrier(0)
    Unit cur, nxt; int ui = 0;
    if (!S.next(0, cur)) return;
    f32x4 acc[2][2][4][2];
#pragma unroll
    for (int a = 0; a < 2; ++a)
#pragma unroll
        for (int b = 0; b < 2; ++b)
#pragma unroll
            for (int m = 0; m < 4; ++m)
#pragma unroll
                for (int n = 0; n < 2; ++n) acc[a][b][m][n] = (f32x4){0.f, 0.f, 0.f, 0.f};
    bf16x8 At[4][2], B0[2][2], B1[2][2];
    const char* cA = (const char*)g.A + (size_t)cur.pm * tstepA; const char* cB = (const char*)g.Bt + (size_t)cur.pn * tstepB;
    PG8_STAGE(PG8_SB(0, 0), cB, voffB); PG8_STAGE(PG8_SB(0, 1), cB + hstepB, voffB); PG8_STAGE(PG8_SA(0, 0), cA, voffA); PG8_STAGE(PG8_SA(0, 1), cA + hstepA, voffA);
    if (wr == 1) PG8_BAR;
    PG8_WAIT_V(2); PG8_BAR;
    PG8_STAGE(PG8_SB(1, 0), cB + kstepB, voffB); PG8_STAGE(PG8_SA(1, 0), cA + kstepA, voffA); PG8_STAGE(PG8_SB(1, 1), cB + hstepB + kstepB, voffB);
    PG8_WAIT_V(6); PG8_BAR;
    for (;;) {
        const bool has_next = S.next(ui + 1, nxt);
        const char* nA = has_next ? (const char*)g.A + (size_t)nxt.pm * tstepA : cA; const char* nB = has_next ? (const char*)g.Bt + (size_t)nxt.pn * tstepB : cB;
#pragma unroll 1
        for (int t = 0; t < nt; t += 2) {
            const bool last = (t == nt - 2);
            const char* a1 = cA + (size_t)(t + 1) * kstepA;
            const char* a2 = last ? nA : cA + (size_t)(t + 2) * kstepA; const char* b2 = last ? nB : cB + (size_t)(t + 2) * kstepB;
            const char* a3 = a2 + kstepA; const char* b3 = b2 + kstepB;
            PG8_LDB(B0, 0, 0); PG8_LDB(B1, 0, 1); PG8_SCHED; PG8_LDA(At, 0, 0); PG8_STAGE(PG8_SA(1, 1), a1 + hstepA, voffA);
            PG8_WAIT_V(8); PG8_WAIT_L(0); PG8_BAR; PG8_MMA(0, 0, At, B0); PG8_MMA(0, 1, At, B1); PG8_BAR; PG8_SCHED;
            PG8_LDA(At, 0, 1); PG8_STAGE(PG8_SB(0, 0), b2, voffB); PG8_STAGE(PG8_SB(0, 1), b2 + hstepB, voffB); PG8_STAGE(PG8_SA(0, 0), a2, voffA);
            PG8_WAIT_V(8); PG8_WAIT_L(0); PG8_BAR; PG8_MMA(1, 0, At, B0); PG8_MMA(1, 1, At, B1); PG8_BAR; PG8_SCHED;
            PG8_LDB(B0, 1, 0); PG8_LDB(B1, 1, 1); PG8_SCHED; PG8_LDA(At, 1, 0); PG8_STAGE(PG8_SA(0, 1), a2 + hstepA, voffA);
            PG8_WAIT_V(8); PG8_WAIT_L(0); PG8_BAR; PG8_MMA(0, 0, At, B0); PG8_MMA(0, 1, At, B1); PG8_BAR; PG8_SCHED;
            PG8_LDA(At, 1, 1); PG8_STAGE(PG8_SB(1, 0), b3, voffB); PG8_STAGE(PG8_SB(1, 1), b3 + hstepB, voffB); PG8_STAGE(PG8_SA(1, 0), a3, voffA);
            PG8_WAIT_V(8); PG8_WAIT_L(0); PG8_BAR; PG8_MMA(1, 0, At, B0); PG8_MMA(1, 1, At, B1); PG8_BAR; PG8_SCHED;
        }
        if constexpr (ALIGN_EPI) { if (wr == 0) PG8_BAR; }
        E(acc, cur, wr, wc, fr, fq);
        if (!has_next) break;
#pragma unroll
        for (int a = 0; a < 2; ++a)
#pragma unroll
            for (int b = 0; b < 2; ++b)
#pragma unroll
                for (int m = 0; m < 4; ++m)
#pragma unroll
                    for (int n = 0; n < 2; ++n) acc[a][b][m][n] = (f32x4){0.f, 0.f, 0.f, 0.f};
        cur = nxt; cA = nA; cB = nB; ++ui;
        if constexpr (ALIGN_EPI) { if (wr == 1) PG8_BAR; }
    }
    PG8_WAIT_V(0);
    if constexpr (!ALIGN_EPI) { if (wr == 0) PG8_BAR; }
    PG8_BAR;
#undef PG8_SA
#undef PG8_SB
#undef PG8_STAGE
#undef PG8_LDA
#undef PG8_LDB
#undef PG8_MMA
#undef PG8_WAIT_V
#undef PG8_WAIT_L
#undef PG8_BAR
#undef PG8_SCHED
}
}

namespace att {
#define SBAR() __builtin_amdgcn_sched_barrier(0)
__device__ __forceinline__ int v_st(int k, int c) { const int kk = (k & ~0xC) | ((k & 4) << 1) | ((k & 8) >> 1); return ((kk >> 3) * 4 + (c >> 5)) * 512 + ((kk & 7) * 32 + (c & 31)) * 2; }
__device__ __forceinline__ int v_rd_base(int lane) { return ((lane & 3) << 3) | (((lane >> 2) & 3) << 6) | (((lane >> 4) & 1) << 5) | (((lane >> 5) & 1) << 8); }
constexpr int v_rd_off(int d0, int ks, int half) { return d0 * 512 + ks * 4096 + half * 2048; }
__device__ __forceinline__ int crow(int r, int hi) { return (r & 3) + 8 * (r >> 2) + 4 * hi; }
constexpr int SHM_V = 64 * 128 * 2;
__device__ __forceinline__ void mask_tile(f32x16& p0, f32x16& p1, int dq) {
    const float NEG = -__builtin_inff();
#pragma unroll
    for (int r = 0; r < 16; ++r) { const int c = (r & 3) + 8 * (r >> 2); if (dq - c < 0) p0[r] = NEG; if (dq - c - 32 < 0) p1[r] = NEG; }
}
__device__ __forceinline__ void partialSM(f32x16& p0, f32x16& p1, float& m_reg, float& mn, float& alpha, const float C2  ) {
    float pmax = p0[0];
#pragma unroll
    for (int r = 1; r < 16; ++r) pmax = fmaxf(pmax, p0[r]);
#pragma unroll
    for (int r = 0; r < 16; ++r) pmax = fmaxf(pmax, p1[r]);
    { auto rr = __builtin_amdgcn_permlane32_swap(__float_as_uint(pmax), __float_as_uint(pmax), false, false); pmax = fmaxf(__uint_as_float(rr[0]), __uint_as_float(rr[1])); }
    if (__builtin_expect(__all((pmax - m_reg) * C2 <= 11.5f), 1)) { mn = m_reg; alpha = 1.f; }
    else { mn = fmaxf(m_reg, pmax); alpha = __builtin_amdgcn_exp2f((m_reg - mn) * C2); m_reg = mn; }
    const float mnL = -mn * C2;
#pragma unroll
    for (int r = 0; r < 16; ++r) p0[r] = fmaf(p0[r], C2, mnL);
#pragma unroll
    for (int r = 0; r < 16; ++r) p1[r] = fmaf(p1[r], C2, mnL);
#pragma unroll
    for (int r = 0; r < 16; ++r) p0[r] = __builtin_amdgcn_exp2f(p0[r]);
}
__device__ __forceinline__ void finishSM(f32x16& p0, f32x16& p1, float alpha, float& l_reg, bf16x8& pa0, bf16x8& pa1, bf16x8& pa2, bf16x8& pa3) {
#pragma unroll
    for (int r = 0; r < 16; ++r) p1[r] = __builtin_amdgcn_exp2f(p1[r]);
    float ps = 0;
#pragma unroll
    for (int r = 0; r < 16; ++r) ps += p0[r];
#pragma unroll
    for (int r = 0; r < 16; ++r) ps += p1[r];
    { auto rr = __builtin_amdgcn_permlane32_swap(__float_as_uint(ps), __float_as_uint(ps), false, false); ps = __uint_as_float(rr[0]) + __uint_as_float(rr[1]); }
    l_reg = l_reg * alpha + ps;
#define PK4(P, B_, OUT) do { unsigned a0 = cvt_pk_bf16(P[B_+0], P[B_+1]), a1 = cvt_pk_bf16(P[B_+2], P[B_+3]); \
        unsigned b0 = cvt_pk_bf16(P[B_+4], P[B_+5]), b1 = cvt_pk_bf16(P[B_+6], P[B_+7]); \
        auto r0 = __builtin_amdgcn_permlane32_swap(a0, b0, false, false); auto r1 = __builtin_amdgcn_permlane32_swap(a1, b1, false, false); \
        u32x4 w = {r0[0], r1[0], r0[1], r1[1]}; OUT = *reinterpret_cast<bf16x8*>(&w); } while (0)
    PK4(p0, 0, pa0); PK4(p0, 8, pa1); PK4(p1, 0, pa2); PK4(p1, 8, pa3);
#undef PK4
}
template <int KB, int DQK>
__device__ __forceinline__ void qkt(f32x16& p0, f32x16& p1, const LAS unsigned char* K_lds, int r32, int hi, const bf16x8* qr) {
    constexpr int KROW = DQK * 2, SHM_K = 64 * KROW;
    p0 = f32x16{}; p1 = f32x16{};
    const int sw = (r32 & 7) << 4;
#pragma unroll
    for (int d0 = 0; d0 < DQK / 16; ++d0) { const LAS unsigned char* a = K_lds + KB * SHM_K + r32 * KROW + ((d0 * 32 + hi * 16) ^ sw);
        const bf16x8 b0 = *(const LAS bf16x8*)a, b1 = *(const LAS bf16x8*)(a + 32 * KROW);
        p0 = __builtin_amdgcn_mfma_f32_32x32x16_bf16(b0, qr[d0], p0, 0, 0, 0);
        p1 = __builtin_amdgcn_mfma_f32_32x32x16_bf16(b1, qr[d0], p1, 0, 0, 0); }
}
template <int VB>
__device__ __forceinline__ void pv_tile(f32x16* o, int vb0, bf16x8 pa0, bf16x8 pa1, bf16x8 pa2, bf16x8 pa3) {
#define TRRD(dst, off) asm volatile("ds_read_b64_tr_b16 %0, %1 offset:%2" : "=&v"(dst) : "v"(vb0), "i"(off) : "memory")
#define PV_D0(d0) do { s16x4 l0, l1, l2, l3, h0, h1, h2, h3; constexpr int b_ = VB * SHM_V + v_rd_off(d0, 0, 0); \
        TRRD(l0, b_); TRRD(h0, b_ + 2048); TRRD(l1, b_ + 4096); TRRD(h1, b_ + 6144); TRRD(l2, b_ + 8192); TRRD(h2, b_ + 10240); TRRD(l3, b_ + 12288); TRRD(h3, b_ + 14336); \
        asm volatile("s_waitcnt lgkmcnt(0)" ::: "memory"); SBAR(); \
        o[d0] = __builtin_amdgcn_mfma_f32_32x32x16_bf16(pa0, (bf16x8){l0[0], l0[1], l0[2], l0[3], h0[0], h0[1], h0[2], h0[3]}, o[d0], 0, 0, 0); \
        o[d0] = __builtin_amdgcn_mfma_f32_32x32x16_bf16(pa1, (bf16x8){l1[0], l1[1], l1[2], l1[3], h1[0], h1[1], h1[2], h1[3]}, o[d0], 0, 0, 0); \
        o[d0] = __builtin_amdgcn_mfma_f32_32x32x16_bf16(pa2, (bf16x8){l2[0], l2[1], l2[2], l2[3], h2[0], h2[1], h2[2], h2[3]}, o[d0], 0, 0, 0); \
        o[d0] = __builtin_amdgcn_mfma_f32_32x32x16_bf16(pa3, (bf16x8){l3[0], l3[1], l3[2], l3[3], h3[0], h3[1], h3[2], h3[3]}, o[d0], 0, 0, 0); } while (0)
    PV_D0(0); PV_D0(1); PV_D0(2); PV_D0(3);
#undef PV_D0
#undef TRRD
}
template <int DQK, bool CAUSAL>
__device__ __forceinline__ void attn_unit(LAS unsigned char* lds, const bf16_t* Q, int ldq, const bf16_t* Kn, int ldk, const bf16_t* Kr, int ldkr, const bf16_t* V, int ldv,
                                          bf16_t* O, int ldo, int q0, int NT, float C2) {
    constexpr int KROW = DQK * 2, SHM_K = 64 * KROW, ND = DQK / 16;
    int tid = threadIdx.x; asm volatile("" : "+v"(tid));
    const int wid = __builtin_amdgcn_readfirstlane(tid >> 6), lane = tid & 63, r32 = lane & 31, hi = lane >> 5;
    LAS unsigned char* V_lds = lds; LAS unsigned char* K_lds = lds + 2 * SHM_V;
    LAS float* ws = (LAS float*)(lds + 2 * SHM_V + 2 * SHM_K) + wid * 64; LAS float* li_l = ws; LAS float* al_l = ws + 32;
    bf16x8 qr[ND];
#pragma unroll
    for (int d0 = 0; d0 < ND; ++d0) qr[d0] = *(const bf16x8*)(Q + (size_t)(wid * 32 + r32) * ldq + d0 * 16 + hi * 8);
    float m_reg = -1e30f, l_reg = 0.f; f32x16 o[4] = {};
    const int sr = tid >> 4, sc = (tid & 15) * 8, vst0 = v_st(sr, sc), vst1 = v_st(32 + sr, sc);
    const int kws0 = sr * KROW + ((sc * 2) ^ ((sr & 7) << 4)), kws1 = kws0 + 32 * KROW;
    const int rr_ = tid >> 3, rc_ = (tid & 7) * 8, kwsr = rr_ * KROW + ((256 + rc_ * 2) ^ ((rr_ & 7) << 4));
    const int vb0 = (int)(unsigned)(uintptr_t)V_lds + v_rd_base(lane);
    const int qlo = q0 + wid * 32, qm = qlo + r32 - 4 * hi;
    bf16x8 st_v0, st_v1, st_k0, st_k1, st_kr;
#define ATT_LOAD(t) do { const int kb_ = (t) * 64; \
        st_v0 = *(const bf16x8*)(V + (size_t)(kb_ + sr) * ldv + sc); st_v1 = *(const bf16x8*)(V + (size_t)(kb_ + 32 + sr) * ldv + sc); \
        st_k0 = *(const bf16x8*)(Kn + (size_t)(kb_ + sr) * ldk + sc); st_k1 = *(const bf16x8*)(Kn + (size_t)(kb_ + 32 + sr) * ldk + sc); \
        if constexpr (DQK == 192) st_kr = *(const bf16x8*)(Kr + (size_t)(kb_ + rr_) * ldkr + rc_); } while (0)
#define ATT_WRITE(BUF) do { *(LAS bf16x8*)(V_lds + (BUF) * SHM_V + vst0) = st_v0; *(LAS bf16x8*)(V_lds + (BUF) * SHM_V + vst1) = st_v1; \
        *(LAS bf16x8*)(K_lds + (BUF) * SHM_K + kws0) = st_k0; *(LAS bf16x8*)(K_lds + (BUF) * SHM_K + kws1) = st_k1; \
        if constexpr (DQK == 192) *(LAS bf16x8*)(K_lds + (BUF) * SHM_K + kwsr) = st_kr; } while (0)
#define ATT_STEP(BUF, t) do { \
        ATT_WRITE(BUF); __syncthreads(); \
        if ((t) + 1 < NT) ATT_LOAD((t) + 1); \
        f32x16 p0, p1; qkt<BUF, DQK>(p0, p1, K_lds, r32, hi, qr); \
        if constexpr (CAUSAL) { const int kb_ = (t) * 64; if (kb_ + 63 > qlo) mask_tile(p0, p1, qm - kb_); } \
        float mn, alpha; partialSM(p0, p1, m_reg, mn, alpha, C2); \
        if (__any(alpha < 1.f)) { if (hi == 0) al_l[r32] = alpha; asm volatile("s_waitcnt lgkmcnt(0)" ::: "memory"); \
            _Pragma("unroll") for (int d_ = 0; d_ < 4; ++d_) _Pragma("unroll") for (int r = 0; r < 16; ++r) o[d_][r] *= al_l[crow(r, hi)]; } \
        bf16x8 pa0, pa1, pa2, pa3; finishSM(p0, p1, alpha, l_reg, pa0, pa1, pa2, pa3); SBAR(); \
        pv_tile<BUF>(o, vb0, pa0, pa1, pa2, pa3); } while (0)
    ATT_LOAD(0);
    for (int t = 0; t < NT; t += 2) { ATT_STEP(0, t); ATT_STEP(1, t + 1); }
#undef ATT_LOAD
#undef ATT_WRITE
#undef ATT_STEP
    if (hi == 0) li_l[r32] = l_reg; asm volatile("s_waitcnt lgkmcnt(0)" ::: "memory");
    float rli[16];
#pragma unroll
    for (int r = 0; r < 16; ++r) rli[r] = __builtin_amdgcn_rcpf(li_l[crow(r, hi)]);
    bf16_t* Ow = O + (size_t)(wid * 32) * ldo;
#pragma unroll
    for (int r = 0; r < 16; ++r) { const int orow = crow(r, hi);
#pragma unroll
        for (int d0 = 0; d0 < 4; ++d0) { const float v = o[d0][r] * rli[r]; const float vn = __shfl_xor(v, 1);
            if ((r32 & 1) == 0) *(unsigned*)(Ow + (size_t)orow * ldo + d0 * 32 + r32) = cvt_pk_bf16(v, vn); } }
    __syncthreads();
}
#undef SBAR
__constant__ unsigned char MLA_BINS[16][8] = {
    {0x0F, 0x08, 0xFF, 0xFF, 0xFF, 0xFF, 0xFF, 0xFF}, {0x1F, 0x18, 0x00, 0xFF, 0xFF, 0xFF, 0xFF, 0xFF}, {0x2F, 0x09, 0xFF, 0xFF, 0xFF, 0xFF, 0xFF, 0xFF}, {0x0E, 0x19, 0xFF, 0xFF, 0xFF, 0xFF, 0xFF, 0xFF},
    {0x1E, 0x29, 0x10, 0xFF, 0xFF, 0xFF, 0xFF, 0xFF}, {0x2E, 0x0A, 0xFF, 0xFF, 0xFF, 0xFF, 0xFF, 0xFF}, {0x0D, 0x1A, 0xFF, 0xFF, 0xFF, 0xFF, 0xFF, 0xFF}, {0x1D, 0x2A, 0x20, 0xFF, 0xFF, 0xFF, 0xFF, 0xFF},
    {0x2D, 0x0B, 0xFF, 0xFF, 0xFF, 0xFF, 0xFF, 0xFF}, {0x0C, 0x1B, 0xFF, 0xFF, 0xFF, 0xFF, 0xFF, 0xFF}, {0x1C, 0x2B, 0xFF, 0xFF, 0xFF, 0xFF, 0xFF, 0xFF}, {0x2C, 0x28, 0x03, 0xFF, 0xFF, 0xFF, 0xFF, 0xFF},
    {0x07, 0x17, 0x06, 0x01, 0xFF, 0xFF, 0xFF, 0xFF}, {0x27, 0x16, 0x05, 0x13, 0xFF, 0xFF, 0xFF, 0xFF}, {0x26, 0x15, 0x25, 0x23, 0x11, 0xFF, 0xFF, 0xFF}, {0x04, 0x14, 0x24, 0x02, 0x12, 0x22, 0x21, 0xFF}};
}

constexpr size_t MiB = 1u << 20;
constexpr size_t al256(size_t x) { return (x + 255) & ~(size_t)255; }
constexpr size_t WS_CTL = 0, CTL_ZERO_BYTES = 64 * 1024;
constexpr size_t SZ_GU = (size_t)2 * DFF * DM * 2, SZ_DN = (size_t)DM * DFF * 2;
constexpr size_t WS_GU = 1 * MiB, WS_DN = WS_GU + 8 * SZ_GU, WS_WOUT = WS_DN + 8 * SZ_DN;
constexpr size_t WS_MEMW = WS_WOUT + (size_t)4 * DM * DM * 2;
constexpr size_t WS_AIN = WS_MEMW + (size_t)4 * 1024 * DM * 2;
constexpr size_t WS_GLU = WS_AIN + (size_t)2 * DM * DM * 2;
constexpr size_t WS_BIN = WS_GLU + (size_t)2 * TOKW * TOKW * 2;
constexpr size_t WS_UQ = WS_BIN + (size_t)2 * 1024 * DM * 2;
constexpr size_t WS_DKV = WS_UQ + (size_t)2 * NH * DQKH * QRANK * 2;
constexpr size_t WS_UKV = WS_DKV + (size_t)768 * DM * 2;
constexpr size_t WS_TF = WS_UKV + (size_t)3072 * KVRANK * 2;
constexpr size_t WS_GM = WS_TF + (size_t)2 * S5G * 256 * 384 * 2;
constexpr size_t WS_L16 = WS_GM + (size_t)2 * S5G * 256 * 256 * 2;
constexpr size_t WS_COS = WS_L16 + (size_t)2 * S5G * S5P * 2 * 4, WS_SIN = WS_COS + (size_t)M * 32 * 4;
constexpr size_t WS_MEMN = WS_SIN + (size_t)M * 32 * 4;
constexpr size_t WS_MKV = WS_MEMN + (size_t)4 * 1024 * DM * 2;
constexpr size_t WS_HB = WS_MKV + (size_t)4 * 1024 * 1024 * 2;
constexpr size_t WS_FB = WS_HB + (size_t)M * DM * 2;
constexpr size_t WS_CAT = WS_FB + (size_t)M * DM * 2;
constexpr size_t WS_QMEM = WS_CAT + (size_t)M * DM * 2;
constexpr size_t WS_HKV = WS_QMEM + (size_t)M * MEMW * 2;
constexpr size_t WS_CKV = WS_HKV + (size_t)M * DM * 2;
constexpr size_t WS_SSQ = WS_CKV + (size_t)M * KVRANK * 2;
constexpr size_t WS_RS = WS_SSQ + (size_t)2 * M * 8 * 4;
constexpr size_t WS_KR = WS_RS + (size_t)M * 4;
constexpr size_t WS_KN = WS_KR + (size_t)M * DROPE * 2, WS_VV = WS_KN + (size_t)M * TOKW * 2;
constexpr size_t WS_XB = WS_VV + (size_t)M * TOKW * 2;
constexpr size_t WS_ACT = WS_XB + (size_t)M * DM * 2;
constexpr size_t WS_UH = WS_ACT;
constexpr size_t WS_SEND = WS_UH + (size_t)S5G * NCHUNK * 384 * 2;
constexpr size_t WS_Y = WS_SEND + (size_t)S5G * NCHUNK * 128 * 4;
constexpr size_t WS_CQ = WS_ACT, WS_Q = WS_CQ + (size_t)M * QRANK * 2;
constexpr size_t WS_END = WS_ACT + (size_t)M * DFF * 2;
static_assert(WS_Y + (size_t)S5G * NCHUNK * 256 * 2 <= WS_END && WS_Q + (size_t)M * NH * DQKH * 2 <= WS_END, "mixer scratch fits the activation buffer");
static_assert(WS_END <= (size_t)1408 * MiB, "d_ws map");

constexpr int NWAVES = 8;
constexpr int RING_OFF = 0, RING_BYTES = 131072;
constexpr int LDSCTL_OFF = RING_BYTES, MISC_OFF = LDSCTL_OFF + 320;
constexpr int LDS_BYTES = 147456;

typedef GAS unsigned gu32;
#define RLX_AGENT __ATOMIC_RELAXED, __HIP_MEMORY_SCOPE_AGENT
#define LDS_WAIT() asm volatile("s_waitcnt lgkmcnt(0)" ::: "memory")
#define VM_WAIT() asm volatile("s_waitcnt vmcnt(0)" ::: "memory")
__device__ __forceinline__ unsigned f2bf(float f) { unsigned u = __builtin_bit_cast(unsigned, f); return (u + 0x7fffu + ((u >> 16) & 1u)) >> 16; }
__device__ __forceinline__ unsigned pk2(float lo, float hi) { return f2bf(lo) | (f2bf(hi) << 16); }

#define XB_TMO      128
#define XB_XCNT(j)  (256  + 64 * (j))
#define XB_XSUB(j)  (1280 + 64 * (j))
#define XB_XGEN(j)  (2304 + 64 * (j))
#define XB_TOP      3328
#define XB_TOPGEN   3392
#define XCD_BAR_WORDS 3456
#define XB_SPIN_CAP (1u << 18)
__device__ __forceinline__ unsigned xb_ld(unsigned* p)              { return __hip_atomic_load(p, __ATOMIC_RELAXED, __HIP_MEMORY_SCOPE_AGENT); }
__device__ __forceinline__ unsigned xb_add(unsigned* p, unsigned v) { return __hip_atomic_fetch_add(p, v, __ATOMIC_RELAXED, __HIP_MEMORY_SCOPE_AGENT); }
__device__ __forceinline__ unsigned xb_xcc_id() { return (unsigned)__builtin_amdgcn_s_getreg((3 << 11) | 20) & 0xFu; }
#define XB_SPIN(cond, bar) do { unsigned _sp = 0; while (cond) { __builtin_amdgcn_s_sleep(1); \
    if ((++_sp & 255u) == 0u) { if (xb_ld(&(bar)[XB_TMO])) break; if (_sp > XB_SPIN_CAP) { atomicAdd(&(bar)[XB_TMO], 1u); break; } } } } while (0)
struct XcdBarrier { unsigned* bar; unsigned x; volatile LAS unsigned* st; };
__device__ __forceinline__ XcdBarrier xcd_barrier_post(unsigned* bar, volatile LAS unsigned* st) {
    XcdBarrier b; b.bar = bar; b.x = xb_xcc_id(); b.st = st;
    if (threadIdx.x == 0) (void)xb_add(&bar[XB_XCNT(b.x)], 1u);
    return b;
}
__device__ __forceinline__ void xcd_barrier_complete(unsigned* bar, unsigned x, unsigned& nloc, unsigned& nx) {
    const unsigned G = gridDim.x * gridDim.y * gridDim.z;
    unsigned sum, cnt, mine, sp = 0u;
    for (;;) {
        sum = 0u; cnt = 0u; mine = 0u;
#pragma unroll
        for (unsigned j = 0; j < 16; ++j) { const unsigned c = xb_ld(&bar[XB_XCNT(j)]); sum += c; cnt += (c > 0u) ? 1u : 0u; mine = (j == x) ? c : mine; }
        if (sum == G) break;
        __builtin_amdgcn_s_sleep(1);
        if ((++sp & 255u) == 0u) { if (xb_ld(&bar[XB_TMO])) break; if (sp > XB_SPIN_CAP) { atomicAdd(&bar[XB_TMO], 1u); break; } }
    }
    nloc = mine > 0u ? mine : 1u; nx = cnt > 0u ? cnt : 1u;
}
__device__ __forceinline__ void xcd_barrier(const XcdBarrier& b) {
    asm volatile("s_waitcnt vmcnt(0)" ::: "memory");
    __syncthreads();
    if (threadIdx.x == 0) {
        unsigned* bar = b.bar;
        __builtin_amdgcn_s_waitcnt(0);
        unsigned nloc = b.st[0], nx = b.st[1];
        if (nloc == 0u) { xcd_barrier_complete(bar, b.x, nloc, nx); b.st[0] = nloc; b.st[1] = nx; }
        const unsigned old = xb_add(&bar[XB_XSUB(b.x)], 1u);
        const unsigned gen = old / nloc;
        if (old + 1u == (gen + 1u) * nloc) {
            __builtin_amdgcn_fence(__ATOMIC_RELEASE, "agent");
            asm volatile("s_waitcnt vmcnt(0)" ::: "memory");
            const unsigned og = xb_add(&bar[XB_TOP], 1u);
            const unsigned tg = og / nx;
            if (og + 1u == (tg + 1u) * nx) xb_add(&bar[XB_TOPGEN], 1u);
            else XB_SPIN(xb_ld(&bar[XB_TOPGEN]) == tg, bar);
            __builtin_amdgcn_fence(__ATOMIC_ACQUIRE, "agent");
            xb_add(&bar[XB_XGEN(b.x)], 1u);
            asm volatile("s_waitcnt vmcnt(0)" ::: "memory");
        } else {
            XB_SPIN(xb_ld(&bar[XB_XGEN(b.x)]) == gen, bar);
            __builtin_amdgcn_fence(__ATOMIC_ACQUIRE, "agent");
            asm volatile("s_waitcnt vmcnt(0)" ::: "memory");
        }
    }
    __syncthreads();
}

struct Args { const float* in[30]; float* out; unsigned char* wsp; int ph_lo, ph_hi; };
struct Frame {
    LAS unsigned char* lds;
    int tid, lane, wave, vcu, G;
};
__device__ __forceinline__ float wave_sum(float v) {
#pragma unroll
    for (int o = 1; o < 64; o <<= 1) v += __shfl_xor(v, o);
    return v;
}
__device__ __forceinline__ void sincos_d(double a, float& s, float& c) {
    const double n = __builtin_rint(a * 0.63661977236758134308); const float r = (float)(__builtin_fma(-n, 1.57079632679489661923, a) - n * 6.123233995736766e-17);
    const float r2 = r * r;
    const float sp = r * (1.0f + r2 * (-1.6666667e-1f + r2 * (8.3333333e-3f + r2 * (-1.9841270e-4f + r2 * (2.7557319e-6f + r2 * (-2.5052108e-8f))))));
    const float cp = 1.0f + r2 * (-0.5f + r2 * (4.1666667e-2f + r2 * (-1.3888889e-3f + r2 * (2.4801587e-5f + r2 * (-2.7557319e-7f + r2 * 2.0876757e-9f)))));
    const int q = (int)((long long)n & 3);
    const float ss = (q & 1) ? cp : sp, cc = (q & 1) ? sp : cp;
    s = (q & 2) ? -ss : ss; c = ((q + 1) & 2) ? -cc : cc;
}

__constant__ double ROPE_INV_FREQ[32] = {1.0, 0.7498942093324559, 0.5623413251903491, 0.4216965034285822, 0.31622776601683794, 0.23713737056616552, 0.1778279410038923, 0.1333521432163324, 0.1, 0.07498942093324558, 0.05623413251903491, 0.042169650342858224, 0.03162277660168379, 0.023713737056616554, 0.01778279410038923, 0.01333521432163324, 0.01, 0.007498942093324558, 0.005623413251903491, 0.004216965034285823, 0.0031622776601683794, 0.0023713737056616554, 0.0017782794100389228, 0.001333521432163324, 0.001, 0.0007498942093324559, 0.0005623413251903491, 0.00042169650342858224, 0.00031622776601683794, 0.00023713737056616554, 0.00017782794100389227, 0.0001333521432163324};
enum { MAP_PLAIN = 0, MAP_GATE = 1, MAP_UP = 2, MAP_ROPE64 = 3, MAP_UQ = 4 };
__device__ __forceinline__ int rope_pos(int d) { const int half = d >> 5, i = d & 31; return 8 * (i >> 2) + 4 * half + (i & 3); }
__device__ __forceinline__ int map_row(int mode, int n) {
    if (mode == MAP_GATE) return (n >> 7) * 256 + (n & 127);
    if (mode == MAP_UP) return (n >> 7) * 256 + 128 + (n & 127);
    if (mode == MAP_ROPE64) return rope_pos(n);
    if (mode == MAP_UQ) { const int h = n / DQKH, j = n - h * DQKH; return j < DNOPE ? n : h * DQKH + DNOPE + rope_pos(j - DNOPE); }
    return n;
}
__device__ __forceinline__ void transpose_item(const float* W, int K, int N, bf16_t* WT, int ldo, int row_off, int mode, const float* kgain, LAS float* scrf, int item, int lane) {
    LAS unsigned* scr = (LAS unsigned*)scrf;
    const int nblk = N / 64, kb = item / nblk, nb = item % nblk, k0 = 64 * kb, n0 = 64 * nb;
    const float* src = W + (size_t)k0 * N + n0 + lane;
#pragma unroll
    for (int half = 0; half < 2; ++half) { float v[32];
#pragma unroll
        for (int i = 0; i < 32; ++i) v[i] = src[(size_t)(half * 32 + i) * N];
#pragma unroll
        for (int i = 0; i < 16; ++i) { const int k = k0 + half * 32 + 2 * i; const float g0 = kgain ? kgain[k] : 1.0f, g1 = kgain ? kgain[k + 1] : 1.0f;
            scr[lane * 33 + half * 16 + i] = pk2(v[2 * i] * g0, v[2 * i + 1] * g1); } }
    LDS_WAIT(); asm volatile("" ::: "memory");
    const int c = lane & 7;
#pragma unroll
    for (int j = 0; j < 8; ++j) { const int n = (lane >> 3) + 8 * j; const LAS unsigned* p = scr + n * 33 + c * 4;
        u32x4 o; o.x = p[0]; o.y = p[1]; o.z = p[2]; o.w = p[3];
        *(GAS u32x4*)(WT + (size_t)(row_off + map_row(mode, n0 + n)) * ldo + k0 + 8 * c) = o; }
    LDS_WAIT(); asm volatile("" ::: "memory");
}
__device__ __forceinline__ void rms_row_to_bf16(const float* xrow, const float* gain, bf16_t* orow, int lane, bf16_t* xbrow = nullptr) {
    f32x4 v[8]; float s = 0.f;
#pragma unroll
    for (int j = 0; j < 4; ++j) { v[2 * j] = *(const f32x4*)(xrow + j * 512 + lane * 8); v[2 * j + 1] = *(const f32x4*)(xrow + j * 512 + lane * 8 + 4); }
    if (xbrow) {
#pragma unroll
        for (int j = 0; j < 4; ++j) *(u32x4*)(xbrow + j * 512 + lane * 8) = pack8(v[2 * j], v[2 * j + 1]); }
#pragma unroll
    for (int j = 0; j < 8; ++j) s += (v[j][0] * v[j][0] + v[j][1] * v[j][1]) + (v[j][2] * v[j][2] + v[j][3] * v[j][3]);
    const float rstd = 1.0f / sqrtf(wave_sum(s) * (1.0f / DM) + EPS);
#pragma unroll
    for (int j = 0; j < 4; ++j) { const f32x4 g0 = *(const f32x4*)(gain + j * 512 + lane * 8), g1 = *(const f32x4*)(gain + j * 512 + lane * 8 + 4);
        *(u32x4*)(orow + j * 512 + lane * 8) = pack8(v[2 * j] * rstd * g0, v[2 * j + 1] * rstd * g1); }
}
__device__ __forceinline__ void x_row_to_bf16(const float* xrow, bf16_t* xbrow, float* rs, int lane) {
    f32x4 v[8]; float s = 0.f;
#pragma unroll
    for (int j = 0; j < 4; ++j) { v[2 * j] = *(const f32x4*)(xrow + j * 512 + lane * 8); v[2 * j + 1] = *(const f32x4*)(xrow + j * 512 + lane * 8 + 4); }
#pragma unroll
    for (int j = 0; j < 8; ++j) s += (v[j][0] * v[j][0] + v[j][1] * v[j][1]) + (v[j][2] * v[j][2] + v[j][3] * v[j][3]);
    const float rstd = 1.0f / sqrtf(wave_sum(s) * (1.0f / DM) + EPS);
#pragma unroll
    for (int j = 0; j < 4; ++j) *(u32x4*)(xbrow + j * 512 + lane * 8) = pack8(v[2 * j], v[2 * j + 1]);
    if (lane == 0) *rs = rstd;
}
__device__ __forceinline__ void s5_precompute_item(const Args& a, unsigned char* ws, LAS unsigned char* lds, int la, int g, int tid) {
    LAS float* lp_re = (LAS float*)lds;
    LAS float* lp_im = lp_re + 17 * 64;
    LAS float* bb_re = lp_im + 17 * 64;
    LAS float* bb_im = bb_re + 64 * 16;
    LAS float* cc_re = bb_im + 64 * 16;
    LAS float* cc_im = cc_re + 16 * 64;
    LAS float* km = cc_im + 16 * 64;
    LAS float* dd = km + 16 * 256;
    const float* lam_re = a.in[11] + (size_t)(la * S5G + g) * S5P; const float* lam_im = a.in[12] + (size_t)(la * S5G + g) * S5P;
    const float* b_re = a.in[13] + (size_t)(la * S5G + g) * S5P * S5C; const float* b_im = a.in[14] + (size_t)(la * S5G + g) * S5P * S5C;
    const float* c_re = a.in[15] + (size_t)(la * S5G + g) * S5C * S5P; const float* c_im = a.in[16] + (size_t)(la * S5G + g) * S5C * S5P;
    const float* dvec = a.in[17] + (size_t)la * TOKW + g * S5C;
    const float dt = expf(a.in[18][la * S5G + g]);
    if (tid < 64) { const int p = tid; const float lr = lam_re[p], li = lam_im[p];
        const double ad = (double)lr * (double)dt, bd = (double)li * (double)dt;
        for (int j = 0; j <= 16; ++j) { float s, c; sincos_d(bd * j, s, c); const float mag = expf((float)(ad * j)); lp_re[j * 64 + p] = mag * c; lp_im[j * 64 + p] = mag * s; }
        float sb, cb, sh, ch; sincos_d(bd, sb, cb); sincos_d(0.5 * bd, sh, ch); (void)ch;
        const float af = (float)ad; const float em1 = af * (1.f + af * (0.5f + af * (1.f / 6 + af * (1.f / 24 + af * (1.f / 120 + af * (1.f / 720))))));
        const float xr = em1 * cb - 2.f * sh * sh, xi = (em1 + 1.f) * sb;
        const float den = 1.f / (lr * lr + li * li); const float cr = (xr * lr + xi * li) * den, ci = (xi * lr - xr * li) * den;
        for (int c = 0; c < 16; ++c) { const float br = b_re[p * 16 + c], bi = b_im[p * 16 + c]; bb_re[p * 16 + c] = cr * br - ci * bi; bb_im[p * 16 + c] = cr * bi + ci * br; }
        float* l16 = (float*)(ws + WS_L16) + ((size_t)(la * S5G + g) * S5P + p) * 2; l16[0] = lp_re[16 * 64 + p]; l16[1] = lp_im[16 * 64 + p];
    }
    for (int i = tid; i < 1024; i += 512) { cc_re[i] = c_re[i]; cc_im[i] = c_im[i]; }
    if (tid < 16) dd[tid] = dvec[tid];
    __syncthreads();
    for (int e = tid; e < 4096; e += 512) { const int j = e >> 8, co = (e >> 4) & 15, ci = e & 15; float s = 0.f;
        for (int p = 0; p < 64; ++p) { const float zr = cc_re[co * 64 + p] * lp_re[j * 64 + p] - cc_im[co * 64 + p] * lp_im[j * 64 + p], zi = cc_re[co * 64 + p] * lp_im[j * 64 + p] + cc_im[co * 64 + p] * lp_re[j * 64 + p];
            s += zr * bb_re[p * 16 + ci] - zi * bb_im[p * 16 + ci]; }
        km[e] = s; }
    __syncthreads();
    bf16_t* TF = (bf16_t*)(ws + WS_TF) + ((size_t)(la * S5G + g) * 256) * 384;
    for (int pc = tid; pc < 256 * 48; pc += 512) { const int n = pc / 48, k0 = (pc % 48) * 8, to = n >> 4, co = n & 15; float v[8];
        if (k0 < 256) { const int ti = k0 >> 4, ci0 = k0 & 15, j = to - ti;
#pragma unroll
            for (int e = 0; e < 8; ++e) v[e] = j >= 0 ? km[(j * 16 + co) * 16 + ci0 + e] + ((j == 0 && ci0 + e == co) ? dd[co] : 0.f) : 0.f; }
        else { const int im = k0 >= 320, p0 = (k0 - 256) & 63;
#pragma unroll
            for (int e = 0; e < 8; ++e) { const int p = p0 + e; const float cr = cc_re[co * 64 + p], ci = cc_im[co * 64 + p], lr = lp_re[(to + 1) * 64 + p], li = lp_im[(to + 1) * 64 + p];
                v[e] = im ? -(cr * li + ci * lr) : (cr * lr - ci * li); } }
        u32x4 o; o.x = pk2(v[0], v[1]); o.y = pk2(v[2], v[3]); o.z = pk2(v[4], v[5]); o.w = pk2(v[6], v[7]);
        *(GAS u32x4*)(TF + (size_t)n * 384 + k0) = o; }
    bf16_t* GMo = (bf16_t*)(ws + WS_GM) + ((size_t)(la * S5G + g) * 256) * 256;
    for (int pc = tid; pc < 256 * 32; pc += 512) { const int q = pc >> 5, k0 = (pc & 31) * 8, t = k0 >> 4, c0 = k0 & 15; float v[8];
        if (q < 128) { const int p = q & 63, im = q >> 6; const float lr = lp_re[(15 - t) * 64 + p], li = lp_im[(15 - t) * 64 + p];
#pragma unroll
            for (int e = 0; e < 8; ++e) { const float br = bb_re[p * 16 + c0 + e], bi = bb_im[p * 16 + c0 + e]; v[e] = im ? (lr * bi + li * br) : (lr * br - li * bi); } }
        else {
#pragma unroll
            for (int e = 0; e < 8; ++e) v[e] = 0.f; }
        u32x4 o; o.x = pk2(v[0], v[1]); o.y = pk2(v[2], v[3]); o.z = pk2(v[4], v[5]); o.w = pk2(v[6], v[7]);
        *(GAS u32x4*)(GMo + (size_t)q * 256 + k0) = o; }
    __syncthreads();
}
__device__ __forceinline__ void p0_prologue(const Args& a, Frame& F) {
    unsigned char* ws = a.wsp;
    for (int it = F.vcu; it < NA * S5G; it += F.G) s5_precompute_item(a, ws, F.lds, it / S5G, it % S5G, F.tid);
    LAS float* scr = (LAS float*)(F.lds + RING_OFF + F.wave * 16384);
    const int gw = F.vcu * NWAVES + F.wave, NGW = F.G * NWAVES;
    constexpr int I_FF = (DM / 64) * (DFF / 64), I_DN = (DFF / 64) * (DM / 64), I_WO = (DM / 64) * (DM / 64), I_MK = (DM / 64) * (1024 / 64), I_AI = I_WO, I_GL = (TOKW / 64) * (TOKW / 64),
                  I_BI = I_MK, I_UQ = (QRANK / 64) * (NH * DQKH / 64), I_DK = (DM / 64) * (KVRANK / 64), I_KR = (DM / 64) * (DROPE / 64), I_UK = (KVRANK / 64) * (TOKW / 64);
    constexpr int NITEMS = 8 * I_FF * 2 + 8 * I_DN + 4 * I_WO + 4 * I_MK + 2 * I_AI + 2 * I_GL + 2 * I_BI + 2 * I_UQ + I_DK + I_KR + 2 * I_UK;
    for (int it = gw; it < NITEMS; it += NGW) {
        int r = it;
        if (r < 8 * I_FF) { const int f = r / I_FF; transpose_item(a.in[4] + (size_t)f * DM * DFF, DM, DFF, (bf16_t*)(ws + WS_GU + f * SZ_GU), DM, 0, MAP_GATE, a.in[3] + (size_t)((f >> 1) * 6 + (f & 1) * 4) * DM, scr, r % I_FF, F.lane); continue; } r -= 8 * I_FF;
        if (r < 8 * I_FF) { const int f = r / I_FF; transpose_item(a.in[5] + (size_t)f * DM * DFF, DM, DFF, (bf16_t*)(ws + WS_GU + f * SZ_GU), DM, 0, MAP_UP, a.in[3] + (size_t)((f >> 1) * 6 + (f & 1) * 4) * DM, scr, r % I_FF, F.lane); continue; } r -= 8 * I_FF;
        if (r < 8 * I_DN) { const int f = r / I_DN; transpose_item(a.in[6] + (size_t)f * DFF * DM, DFF, DM, (bf16_t*)(ws + WS_DN + f * SZ_DN), DFF, 0, MAP_PLAIN, nullptr, scr, r % I_DN, F.lane); continue; } r -= 8 * I_DN;
        if (r < 4 * I_WO) { const int f = r / I_WO; transpose_item(a.in[7] + (size_t)f * DM * DM, DM, DM, (bf16_t*)(ws + WS_WOUT) + (size_t)f * DM * DM, DM, 0, MAP_PLAIN, nullptr, scr, r % I_WO, F.lane); continue; } r -= 4 * I_WO;
        if (r < 4 * I_MK) { const int f = r / I_MK; transpose_item(a.in[9] + (size_t)f * DM * 1024, DM, 1024, (bf16_t*)(ws + WS_MEMW) + (size_t)f * 1024 * DM, DM, 0, MAP_PLAIN, nullptr, scr, r % I_MK, F.lane); continue; } r -= 4 * I_MK;
        if (r < 2 * I_AI) { const int f = r / I_AI; transpose_item(a.in[10] + (size_t)f * DM * DM, DM, DM, (bf16_t*)(ws + WS_AIN) + (size_t)f * DM * DM, DM, 0, MAP_PLAIN, a.in[3] + (size_t)(f * 6 + 2) * DM, scr, r % I_AI, F.lane); continue; } r -= 2 * I_AI;
        if (r < 2 * I_GL) { const int f = r / I_GL; transpose_item(a.in[19] + (size_t)f * TOKW * TOKW, TOKW, TOKW, (bf16_t*)(ws + WS_GLU) + (size_t)f * TOKW * TOKW, TOKW, 0, MAP_PLAIN, nullptr, scr, r % I_GL, F.lane); continue; } r -= 2 * I_GL;
        if (r < 2 * I_BI) { const int f = r / I_BI; transpose_item(a.in[21] + (size_t)f * DM * 1024, DM, 1024, (bf16_t*)(ws + WS_BIN) + (size_t)f * 1024 * DM, DM, 0, MAP_PLAIN, a.in[3] + (size_t)((f + NA) * 6 + 2) * DM, scr, r % I_BI, F.lane); continue; } r -= 2 * I_BI;
        if (r < 2 * I_UQ) { const int f = r / I_UQ; transpose_item(a.in[23] + (size_t)f * QRANK * NH * DQKH, QRANK, NH * DQKH, (bf16_t*)(ws + WS_UQ) + (size_t)f * NH * DQKH * QRANK, QRANK, 0, MAP_UQ, a.in[22] + f * QRANK, scr, r % I_UQ, F.lane); continue; } r -= 2 * I_UQ;
        if (r < I_DK) { transpose_item(a.in[25], DM, KVRANK, (bf16_t*)(ws + WS_DKV), DM, 0, MAP_PLAIN, a.in[24], scr, r, F.lane); continue; } r -= I_DK;
        if (r < I_KR) { transpose_item(a.in[29], DM, DROPE, (bf16_t*)(ws + WS_DKV), DM, KVRANK, MAP_ROPE64, a.in[24], scr, r, F.lane); continue; } r -= I_KR;
        if (r < I_UK) { transpose_item(a.in[27], KVRANK, TOKW, (bf16_t*)(ws + WS_UKV), KVRANK, 0, MAP_PLAIN, a.in[26], scr, r, F.lane); continue; } r -= I_UK;
        transpose_item(a.in[28], KVRANK, TOKW, (bf16_t*)(ws + WS_UKV), KVRANK, TOKW, MAP_PLAIN, a.in[26], scr, r, F.lane);
    }
    for (int m = gw; m < M; m += NGW) x_row_to_bf16(a.in[0] + (size_t)m * DM, (bf16_t*)(ws + WS_XB) + (size_t)m * DM, (float*)(ws + WS_RS) + m, F.lane);
    for (int m = gw; m < 4 * 1024; m += NGW) { const int l = m >> 10, r = m & 1023; rms_row_to_bf16(a.in[1] + (size_t)r * DM, a.in[8] + l * DM, (bf16_t*)(ws + WS_MEMN) + (size_t)m * DM, F.lane); }
    const int* pos = (const int*)a.in[2];
    for (int e = (F.vcu * 512 + F.tid); e < M * 32; e += F.G * 512) { const int tok = e >> 5, i = e & 31;
        const double inv = ROPE_INV_FREQ[i];
        float s, c; sincos_d((double)pos[tok] * inv, s, c); ((float*)(ws + WS_COS))[e] = c; ((float*)(ws + WS_SIN))[e] = s; }
}
__device__ __forceinline__ void thin_phase(Frame& F, const bf16_t* fsrc, const bf16_t* xbsrc, bf16_t* xbdst, float* xout, const float* gpost, float scale, float* rsdst) {
    constexpr int TR = 4;
    const int gw = F.vcu * NWAVES + F.wave, NGW = F.G * NWAVES, lane = F.lane;
    f32x4 g[8];
#pragma unroll
    for (int j = 0; j < 4; ++j) { g[2 * j] = *(const f32x4*)(gpost + j * 512 + lane * 8); g[2 * j + 1] = *(const f32x4*)(gpost + j * 512 + lane * 8 + 4); }
    for (int m0 = gw; m0 < M; m0 += NGW * TR) {
        u32x4 fw[TR][4], xw[TR][4];
#pragma unroll
        for (int t = 0; t < TR; ++t) { const int m = m0 + t * NGW;
            if (m < M) {
#pragma unroll
                for (int j = 0; j < 4; ++j) { fw[t][j] = *(const u32x4*)(fsrc + (size_t)m * DM + j * 512 + lane * 8); xw[t][j] = *(const u32x4*)(xbsrc + (size_t)m * DM + j * 512 + lane * 8); } } }
#pragma unroll
        for (int t = 0; t < TR; ++t) { const int m = m0 + t * NGW;
            if (m < M) {
                float f[32]; float xv[32];
#pragma unroll
                for (int j = 0; j < 4; ++j) { unpack8(fw[t][j], f + 8 * j); unpack8(xw[t][j], xv + 8 * j); }
                float s = 0.f;
#pragma unroll
                for (int j = 0; j < 32; ++j) s += f[j] * f[j];
                const float rf = scale / sqrtf(wave_sum(s) * (1.0f / DM) + EPS);
                float s2 = 0.f;
#pragma unroll
                for (int j = 0; j < 8; ++j) { f32x4 x;
#pragma unroll
                    for (int e = 0; e < 4; ++e) { x[e] = xv[4 * j + e] + f[4 * j + e] * rf * g[j][e]; s2 += x[e] * x[e]; }
                    if (xout) *(f32x4*)(xout + (size_t)m * DM + (j >> 1) * 512 + lane * 8 + (j & 1) * 4) = x;
                    xv[4 * j] = x[0]; xv[4 * j + 1] = x[1]; xv[4 * j + 2] = x[2]; xv[4 * j + 3] = x[3]; }
                if (!xout) {
#pragma unroll
                    for (int j = 0; j < 4; ++j) *(u32x4*)(xbdst + (size_t)m * DM + j * 512 + lane * 8) = pack8((f32x4){xv[8 * j], xv[8 * j + 1], xv[8 * j + 2], xv[8 * j + 3]}, (f32x4){xv[8 * j + 4], xv[8 * j + 5], xv[8 * j + 6], xv[8 * j + 7]}); }
                const float rx = 1.0f / sqrtf(wave_sum(s2) * (1.0f / DM) + EPS);
                if (lane == 0) rsdst[m] = rx;
            } }
    }
}
__device__ __forceinline__ void s5_scan_phase(Frame& F, unsigned char* ws, int la) {
    const int gw = F.vcu * NWAVES + F.wave, NGW = F.G * NWAVES, p = F.lane;
    const float* SE = (const float*)(ws + WS_SEND); bf16_t* UH = (bf16_t*)(ws + WS_UH);
    for (int it = gw; it < BATCH * S5G; it += NGW) { const int b = it / S5G, g = it % S5G;
        const float* l16 = (const float*)(ws + WS_L16) + ((size_t)(la * S5G + g) * S5P + p) * 2; const float ar = l16[0], ai = l16[1];
        float hr = 0.f, hi = 0.f; const size_t row0 = (size_t)g * NCHUNK + (size_t)b * CPB;
        for (int k0 = 0; k0 < CPB; k0 += 16) { float sr[16], si[16];
#pragma unroll
            for (int k = 0; k < 16; ++k) { sr[k] = SE[(row0 + k0 + k) * 128 + p]; si[k] = SE[(row0 + k0 + k) * 128 + 64 + p]; }
#pragma unroll
            for (int k = 0; k < 16; ++k) { bf16_t* u = UH + (row0 + k0 + k) * 384 + 256; u[p] = (bf16_t)f2bf(hr); u[64 + p] = (bf16_t)f2bf(hi);
                const float nr = ar * hr - ai * hi + sr[k], ni = ar * hi + ai * hr + si[k]; hr = nr; hi = ni; } }
    }
}

__global__ void __launch_bounds__(NWAVES * 64, 2) trunk_fwd(Args args) {
    extern __shared__ __attribute__((aligned(16))) unsigned char lds_raw[];
    Frame F;
    F.lds = (LAS unsigned char*)lds_raw;
    F.tid = threadIdx.x; F.lane = F.tid & 63; F.wave = __builtin_amdgcn_readfirstlane(F.tid >> 6);
    F.G = gridDim.x; { const int bx = blockIdx.x; F.vcu = (F.G % 8 == 0) ? (bx % 8) * (F.G / 8) + bx / 8 : bx; }
    GAS unsigned char* wsg = (GAS unsigned char*)args.wsp;
#define ws ((unsigned char*)wsg)
    volatile LAS unsigned* MISC = (volatile LAS unsigned*)(F.lds + MISC_OFF);
    for (int u = F.tid; u < (LDS_BYTES - LDSCTL_OFF) / 4; u += NWAVES * 64) ((LAS unsigned*)(F.lds + LDSCTL_OFF))[u] = 0u;
    __syncthreads();
    if (!MK_PER_PHASE) (void)xcd_barrier_post((unsigned*)(ws + WS_CTL) + 1024, MISC + 8);
    const int lo = args.ph_lo, hi = args.ph_hi; int pid = 0;
#define PH_ON() (pid >= lo && pid < hi)
#define PH_FRESH() do { int t_ = threadIdx.x; asm volatile("" : "+v"(t_)); F.tid = t_; F.lane = t_ & 63; F.wave = __builtin_amdgcn_readfirstlane(t_ >> 6); wsg = (GAS unsigned char*)args.wsp; asm volatile("" : "+s"(wsg)); } while (0)
#define PH_BAR() do { if (!MK_PER_PHASE && pid >= lo && pid + 1 < hi) { XcdBarrier bar_; bar_.bar = (unsigned*)(ws + WS_CTL) + 1024; bar_.x = xb_xcc_id(); bar_.st = (volatile LAS unsigned*)(F.lds + MISC_OFF) + 8; xcd_barrier(bar_); } PH_FRESH(); } while (0)
#define PH_LOOP(k) for (int rep_ = 0; rep_ <= REPG(k); ++rep_, ({ PH_BAR(); }))
#define PH_LOOP_NB(k) for (int rep_ = 0; rep_ <= REPG(k); ++rep_)
#define PH_END() do { ++pid; } while (0)
#define bx ((int)blockIdx.x)
#define X (args.out)
#define HB ((bf16_t*)(ws + WS_HB))
#define XB ((bf16_t*)(ws + WS_XB))
#define RSV ((float*)(ws + WS_RS))
#define FB ((bf16_t*)(ws + WS_FB))
#define ACT ((bf16_t*)(ws + WS_ACT))
#define CAT ((bf16_t*)(ws + WS_CAT))
#define QMEM ((bf16_t*)(ws + WS_QMEM))

    for (int pass_ = 0; pass_ < NPASS; ++pass_) { PH_FRESH();
    PH_LOOP(0) if (EN(0) && PH_ON()) p0_prologue(args, F);
    PH_END();
    PH_LOOP(1) if (EN(1) && PH_ON()) { pg8::Gemm g{(const bf16_t*)(ws + WS_MEMN), (const bf16_t*)(ws + WS_MEMW), DM, DM, DM}; pg8::MemKvOrder S{F.G, bx}; pg8::EpiMemKv E{(bf16_t*)(ws + WS_MKV)};
        pg8::gemm_phase<pg8::EpiMemKv, pg8::MemKvOrder>(F.lds + RING_OFF, g, S, E); }
    PH_END();

    for (int hl = 0; hl < 2 * DEPTH; ++hl) {
        const int l = hl >> 1, s = hl & 1, ff = l * 2 + s;
#define gl (args.in[3] + (size_t)l * 6 * DM)
        PH_LOOP(2) if (EN(2) && PH_ON()) { pg8::Gemm g{XB, (const bf16_t*)(ws + WS_GU + ff * SZ_GU), DM, DM, DM}; pg8::StaticOrder S; S.init(M / 256, 2 * DFF / 256, F.G, bx); pg8::EpiSwiGLU E{ACT, RSV};
            pg8::gemm_phase<pg8::EpiSwiGLU, pg8::StaticOrder>(F.lds + RING_OFF, g, S, E); }
        PH_END();
        PH_LOOP(3) if (EN(3) && PH_ON()) { pg8::Gemm g{ACT, (const bf16_t*)(ws + WS_DN + ff * SZ_DN), DFF, DFF, DFF}; pg8::StaticOrder S; S.init(M / 256, DM / 256, F.G, bx); pg8::EpiBf16 E{FB, DM};
            pg8::gemm_phase<pg8::EpiBf16, pg8::StaticOrder>(F.lds + RING_OFF, g, S, E); }
        PH_END();
        PH_LOOP(4) if (EN(4) && PH_ON()) {
            const bool fin = (hl == 2 * DEPTH - 1);
            thin_phase(F, FB, XB, rep_ ? (bf16_t*)(ws + WS_ACT) : XB, fin ? X : nullptr, gl + (s == 0 ? 1 : 5) * DM, 0.5f, rep_ ? (float*)(ws + WS_CAT) : RSV); }
        PH_END();
        if (s == 0) {
#define MK ((const bf16_t*)(ws + WS_MKV) + (size_t)l * 1024 * 1024)
            if (l < NA) {
                PH_LOOP(5) if (EN(5) && PH_ON()) { pg8::Gemm g{XB, (const bf16_t*)(ws + WS_AIN) + (size_t)l * DM * DM, DM, DM, DM}; pg8::StaticOrder S; S.init(M / 256, DM / 256, F.G, bx); pg8::EpiAin E{(bf16_t*)(ws + WS_UH), QMEM, RSV};
                    pg8::gemm_phase<pg8::EpiAin, pg8::StaticOrder>(F.lds + RING_OFF, g, S, E); }
                PH_END();
                PH_LOOP(6) if (EN(6) && PH_ON()) { pg8::Gemm g{(const bf16_t*)(ws + WS_UH), (const bf16_t*)(ws + WS_GM) + (size_t)l * S5G * 256 * 256, 256, 384, 256}; pg8::S5Order S{F.G, bx}; pg8::EpiS5State E{(float*)(ws + WS_SEND)};
                    pg8::gemm_phase<pg8::EpiS5State, pg8::S5Order>(F.lds + RING_OFF, g, S, E); }
                PH_END();
                PH_LOOP(7) if (EN(7) && PH_ON()) s5_scan_phase(F, ws, l);
                PH_END();
                PH_LOOP(6) if (EN(6) && PH_ON()) { pg8::Gemm g{(const bf16_t*)(ws + WS_UH), (const bf16_t*)(ws + WS_TF) + (size_t)l * S5G * 256 * 384, 384, 384, 384}; pg8::S5Order S{F.G, bx}; pg8::EpiS5Out E{(bf16_t*)(ws + WS_Y)};
                    pg8::gemm_phase<pg8::EpiS5Out, pg8::S5Order>(F.lds + RING_OFF, g, S, E); }
                PH_END();
                PH_LOOP_NB(8) if (EN(8) && PH_ON()) { pg8::Gemm g{(const bf16_t*)(ws + WS_Y), (const bf16_t*)(ws + WS_GLU) + (size_t)l * TOKW * TOKW, TOKW, 0, TOKW}; pg8::StaticOrder S; S.init(M / 256, TOKW / 256, F.G, bx);
                    pg8::EpiGlu E{(const bf16_t*)(ws + WS_Y), args.in[20] + (size_t)l * TOKW, CAT};
                    pg8::gemm_phase<pg8::EpiGlu, pg8::StaticOrder, 1>(F.lds + RING_OFF, g, S, E); }
            } else {
                const int j = l - NA;
                PH_LOOP(9) if (EN(9) && PH_ON()) { pg8::Gemm g{XB, (const bf16_t*)(ws + WS_BIN) + (size_t)j * 1024 * DM, DM, DM, DM}; pg8::StaticOrder S; S.init(M / 256, 1024 / 256, F.G, bx);
                    pg8::EpiBin E{(bf16_t*)(ws + WS_CQ), (float*)(ws + WS_SSQ), QMEM, RSV};
                    pg8::gemm_phase<pg8::EpiBin, pg8::StaticOrder>(F.lds + RING_OFF, g, S, E); }
                PH_END();
                PH_LOOP(9) if (EN(9) && PH_ON()) { pg8::Gemm g{(const bf16_t*)(ws + WS_CQ), (const bf16_t*)(ws + WS_UQ) + (size_t)j * NH * DQKH * QRANK, QRANK, QRANK, QRANK}; pg8::StaticOrder S; S.init(M / 256, NH * DQKH / 256, F.G, bx);
                    pg8::EpiUq E{(const float*)(ws + WS_SSQ), (const float*)(ws + WS_COS), (const float*)(ws + WS_SIN), (bf16_t*)(ws + WS_Q)};
                    pg8::gemm_phase<pg8::EpiUq, pg8::StaticOrder>(F.lds + RING_OFF, g, S, E); }
                PH_END();
                PH_LOOP_NB(10) if (EN(10) && PH_ON()) {
                    for (int it = F.vcu; it < 256; it += F.G) { const int tri = it >> 4, bin = it & 15;
                        for (int e = 0; e < 8; ++e) { const unsigned code = att::MLA_BINS[bin][e]; if (code == 0xFFu) break;
                            const int bh = tri * 3 + (int)(code >> 4), qb = (int)(code & 15), b = bh / NH, h = bh % NH; const size_t tok0 = (size_t)b * SEQ;
                            att::attn_unit<192, true>(F.lds + RING_OFF, (const bf16_t*)(ws + WS_Q) + (tok0 + qb * 256) * (NH * DQKH) + h * DQKH, NH * DQKH,
                                (const bf16_t*)(ws + WS_KN) + tok0 * TOKW + h * DNOPE, TOKW, (const bf16_t*)(ws + WS_KR) + tok0 * DROPE, DROPE,
                                (const bf16_t*)(ws + WS_VV) + tok0 * TOKW + h * DVH, TOKW, CAT + (tok0 + qb * 256) * DM + h * DVH, DM, qb * 256, 4 * (qb + 1), 0.07216878364870322f * 1.4426950408889634f); } }
                }
            }
            PH_LOOP(11) if (EN(11) && PH_ON()) {
                for (int it = F.vcu; it < BATCH * 4 * (SEQ / 256); it += F.G) { const int b = it >> 6, h = (it >> 4) & 3, qb = it & 15; const size_t tok0 = (size_t)b * SEQ + qb * 256;
                    att::attn_unit<128, false>(F.lds + RING_OFF, QMEM + tok0 * MEMW + h * 128, MEMW, MK + (size_t)b * NMEM * 1024 + h * 128, 1024, nullptr, 0,
                        MK + (size_t)b * NMEM * 1024 + MEMW + h * 128, 1024, CAT + tok0 * DM + TOKW + h * 128, DM, 0, NMEM / 64, 0.08838834764831845f * 1.4426950408889634f); }
            }
            PH_END();
            PH_LOOP(12) if (EN(12) && PH_ON()) { pg8::Gemm g{CAT, (const bf16_t*)(ws + WS_WOUT) + (size_t)l * DM * DM, DM, DM, DM}; pg8::StaticOrder S; S.init(M / 256, DM / 256, F.G, bx); pg8::EpiBf16 E{FB, DM};
                pg8::gemm_phase<pg8::EpiBf16, pg8::StaticOrder>(F.lds + RING_OFF, g, S, E); }
            PH_END();
            PH_LOOP(4) if (EN(4) && PH_ON()) thin_phase(F, FB, XB, rep_ ? (bf16_t*)(ws + WS_ACT) : XB, nullptr, gl + 3 * DM, 1.0f, rep_ ? (float*)(ws + WS_CAT) : RSV);
            PH_END();
        } else if (l == NA - 1) {
            PH_LOOP(13) if (EN(13) && PH_ON()) { pg8::Gemm g{XB, (const bf16_t*)(ws + WS_DKV), DM, DM, DM}; pg8::StaticOrder S; S.init(M / 256, 3, F.G, bx);
                pg8::EpiDkv E{(bf16_t*)(ws + WS_CKV), (float*)(ws + WS_SSQ) + (size_t)M * 8, (const float*)(ws + WS_COS), (const float*)(ws + WS_SIN), (bf16_t*)(ws + WS_KR), RSV};
                pg8::gemm_phase<pg8::EpiDkv, pg8::StaticOrder>(F.lds + RING_OFF, g, S, E); }
            PH_END();
            PH_LOOP(13) if (EN(13) && PH_ON()) { pg8::Gemm g{(const bf16_t*)(ws + WS_CKV), (const bf16_t*)(ws + WS_UKV), KVRANK, KVRANK, KVRANK}; pg8::StaticOrder S; S.init(M / 256, 3072 / 256, F.G, bx);
                pg8::EpiUkv E{(const float*)(ws + WS_SSQ) + (size_t)M * 8, (bf16_t*)(ws + WS_KN), (bf16_t*)(ws + WS_VV)};
                pg8::gemm_phase<pg8::EpiUkv, pg8::StaticOrder>(F.lds + RING_OFF, g, S, E); }
            PH_END();
        }
    }
    }
#undef PH_ON
#undef PH_END
#undef PH_BAR
#undef PH_LOOP
#undef PH_LOOP_NB
#undef ws
#undef bx
#undef X
#undef HB
#undef XB
#undef RSV
#undef FB
#undef ACT
#undef CAT
#undef QMEM
#undef gl
#undef MK
}
constexpr int N_PHASES = 2 + 8 * 3 + 2 * 7 + 2 * 5 + 2;

extern "C" void kernel_launch(void* const* d_in, const int* in_sizes, int n_in, void* d_out, int out_size, void* d_ws, size_t ws_size, hipStream_t stream) {
    static int grid = 0;
    if (grid == 0) {
        if (n_in != 30 || in_sizes[0] != M * DM || out_size != M * DM || ws_size < WS_END) { fprintf(stderr, "kernel_launch: shape / workspace mismatch (n_in %d, in0 %d, out %d, ws %zu, need %zu)\n", n_in, n_in > 0 ? in_sizes[0] : -1, out_size, ws_size, (size_t)WS_END); grid = -1; return; }
        int dev = 0, cus = 0, per_cu = 0;
        if (hipGetDevice(&dev) != hipSuccess || hipDeviceGetAttribute(&cus, hipDeviceAttributeMultiprocessorCount, dev) != hipSuccess) { grid = -1; return; }
        if (hipFuncSetAttribute((const void*)trunk_fwd, hipFuncAttributeMaxDynamicSharedMemorySize, LDS_BYTES) != hipSuccess) { fprintf(stderr, "kernel_launch: hipFuncSetAttribute failed\n"); grid = -1; return; }
        if (hipOccupancyMaxActiveBlocksPerMultiprocessor(&per_cu, (const void*)trunk_fwd, NWAVES * 64, LDS_BYTES) != hipSuccess || per_cu < 1) { fprintf(stderr, "kernel_launch: occupancy query reports %d\n", per_cu); }
        (void)hipGetLastError();
        grid = cus;
    }
    if (grid < 0) return;
    if (hipMemsetAsync((char*)d_ws + WS_CTL, 0, CTL_ZERO_BYTES, stream) != hipSuccess) return;
    Args a{};
    for (int i = 0; i < 30; ++i) a.in[i] = (const float*)d_in[i];
    a.out = (float*)d_out; a.wsp = (unsigned char*)d_ws;
#if MK_PER_PHASE
    for (int p = 0; p < N_PHASES; ++p) { a.ph_lo = p; a.ph_hi = p + 1; hipLaunchKernelGGL(trunk_fwd, dim3(grid), dim3(NWAVES * 64), LDS_BYTES, stream, a); }
#else
    a.ph_lo = 0; a.ph_hi = N_PHASES * NPASS;
    hipLaunchKernelGGL(trunk_fwd, dim3(grid), dim3(NWAVES * 64), LDS_BYTES, stream, a);
#endif
    const hipError_t le = hipPeekAtLastError();
    if (le != hipSuccess) fprintf(stderr, "kernel_launch: launch failed: %s\n", hipGetErrorName(le));
}
```
